# Optimizing an MI355X kernel written in HIP

```python
import math
import jax, jax.numpy as jnp
from jax import lax
import numpy as np

D_MODEL = 1024
BATCH = 32
SEQ = 2048
DEPTH = 2

HEAD_DIM = 64
GRID_W = 64
Q_BLOCK = 128
ROPE_THETA = 10000.0
EPS = 1e-6
FORGET_FLOOR = 1e-6

A_HEADS = 6
A_KV_HEADS = 2
B_HEADS = 6
B_QK_DIM = HEAD_DIM // 2
C_HEADS = 4
C_KEY_DIM = 64
C_VAL_DIM = 64
C_CHUNK = 64

A_WIDTH = A_HEADS * HEAD_DIM
B_WIDTH = B_HEADS * HEAD_DIM
C_WIDTH = C_HEADS * C_VAL_DIM
MIX_WIDTH = A_WIDTH + B_WIDTH + C_WIDTH

IN_SIZES = [A_HEADS * HEAD_DIM, A_KV_HEADS * HEAD_DIM, A_KV_HEADS * HEAD_DIM,
            B_HEADS * 2 * B_QK_DIM, B_HEADS * 2 * B_QK_DIM, B_HEADS * HEAD_DIM,
            C_HEADS * C_KEY_DIM, C_HEADS * C_KEY_DIM, C_HEADS * C_KEY_DIM,
            C_HEADS * C_VAL_DIM, C_HEADS * C_VAL_DIM]
IN_TOTAL = sum(IN_SIZES)
D_FF = 4 * D_MODEL

kernel_name = "hymba_style_bidir_hybrid_encoder"


def rms_norm(x, gain=None):
    xf = x.astype(jnp.float32)
    y = xf * lax.rsqrt(jnp.mean(xf * xf, axis=-1, keepdims=True) + EPS)
    if gain is not None:
        y = y * gain.astype(jnp.float32)
    return y.astype(x.dtype)


def rope_angles(pos, dim):
    inv = ROPE_THETA ** (-jnp.arange(0, dim, 2, dtype=jnp.float32) / dim)
    return pos.astype(jnp.float32)[:, None] * inv[None, :]


def apply_rope(x, ang):
    shape = (1, ang.shape[0]) + (1,) * (x.ndim - 3) + (ang.shape[1],)
    cos = jnp.cos(ang).reshape(shape)
    sin = jnp.sin(ang).reshape(shape)
    xf = x.astype(jnp.float32)
    x1, x2 = jnp.split(xf, 2, axis=-1)
    out = jnp.concatenate([x1 * cos - x2 * sin, x1 * sin + x2 * cos], axis=-1)
    return out.astype(x.dtype)


def axial_rope(x, ang_row, ang_col):
    half = x.shape[-1] // 2
    return jnp.concatenate([apply_rope(x[..., :half], ang_row), apply_rope(x[..., half:], ang_col)], axis=-1)


def blocked_attention(q, k, v):
    B, S, H, dq = q.shape
    Hkv = k.shape[2]
    G = H // Hkv
    dv = v.shape[-1]
    nb = S // Q_BLOCK
    scale = dq ** -0.5
    qb = q.reshape(B, nb, Q_BLOCK, Hkv, G, dq).transpose(1, 0, 2, 3, 4, 5)

    def one_block(qblk):
        s = jnp.einsum('bqkgd,bskd->bkgqs', qblk, k).astype(jnp.float32) * scale
        p = jax.nn.softmax(s, axis=-1).astype(v.dtype)
        return jnp.einsum('bkgqs,bskd->bqkgd', p, v)

    o = lax.map(one_block, qb)
    return o.transpose(1, 0, 2, 3, 4, 5).reshape(B, S, H, dv)


def hgrn2_chunk_scan(q, logf, k, v):
    B, S, H, dk = q.shape
    dv = v.shape[-1]
    n = S // C_CHUNK

    def to_chunks(a):
        return a.reshape(B, n, C_CHUNK, H, a.shape[-1]).transpose(1, 0, 3, 2, 4)

    mask = jnp.tril(jnp.ones((C_CHUNK, C_CHUNK), dtype=bool))[None, None, :, :, None]

    def step(state, inp):
        qi, gi, ki, vi = inp
        bcum = jnp.cumsum(gi, axis=2)
        diff = bcum[:, :, :, None, :] - bcum[:, :, None, :, :]
        decay = jnp.where(mask, jnp.exp(jnp.where(mask, diff, 0.0)), 0.0)
        scores = jnp.einsum('bhtd,bhtsd,bhsd->bhts', qi, decay, ki)
        o = jnp.einsum('bhts,bhse->bhte', scores, vi) + jnp.einsum('bhtd,bhde->bhte', qi * jnp.exp(bcum), state)
        blast = bcum[:, :, -1:, :]
        new_state = jnp.exp(blast[:, :, 0, :])[..., None] * state + jnp.einsum('bhsd,bhse->bhde', ki * jnp.exp(blast - bcum), vi)
        return new_state, o

    init = jnp.zeros((B, H, dk, dv), jnp.float32)
    _, o = lax.scan(step, init, (to_chunks(q), to_chunks(logf), to_chunks(k), to_chunks(v)))
    return o.transpose(1, 0, 3, 2, 4).reshape(B, S, H, dv)


def mixer_axial_gqa(zq, zk, zv, qk_gains, ang_row, ang_col):
    B, S, _ = zq.shape
    q = rms_norm(zq.reshape(B, S, A_HEADS, HEAD_DIM), qk_gains[0])
    k = rms_norm(zk.reshape(B, S, A_KV_HEADS, HEAD_DIM), qk_gains[1])
    v = zv.reshape(B, S, A_KV_HEADS, HEAD_DIM)
    q = axial_rope(q, ang_row, ang_col)
    k = axial_rope(k, ang_row, ang_col)
    return blocked_attention(q, k, v).reshape(B, S, A_WIDTH)


def mixer_diff_attention(zq, zk, zv, lam_params, subln_gain, lam_init, ang):
    B, S, _ = zq.shape
    q = apply_rope(zq.reshape(B, S, B_HEADS, 2, B_QK_DIM), ang)
    k = apply_rope(zk.reshape(B, S, B_HEADS, 2, B_QK_DIM), ang)
    v = zv.reshape(B, S, B_HEADS, HEAD_DIM)
    lp = lam_params.astype(jnp.float32)
    lam = jnp.exp(jnp.sum(lp[0] * lp[1])) - jnp.exp(jnp.sum(lp[2] * lp[3])) + lam_init
    o1 = blocked_attention(q[:, :, :, 0], k[:, :, :, 0], v)
    o2 = blocked_attention(q[:, :, :, 1], k[:, :, :, 1], v)
    o = o1 - lam.astype(o1.dtype) * o2
    o = rms_norm(o, subln_gain) * (1.0 - lam_init)
    return o.reshape(B, S, B_WIDTH)


def mixer_hgrn2(zq, zf_fwd, zf_bwd, zi, zg, lb, norm_gain):
    B, S, _ = zq.shape

    def heads(a, d):
        return a.reshape(B, S, C_HEADS, d).astype(jnp.float32)

    q = jax.nn.silu(heads(zq, C_KEY_DIM)) * (C_KEY_DIM ** -0.5)
    v = heads(zi, C_VAL_DIM)
    lb = lb.reshape(C_HEADS, C_KEY_DIM)

    def gates(zf):
        zf = heads(zf, C_KEY_DIM)
        f = lb + (1.0 - lb) * jax.nn.sigmoid(zf)
        logf = jnp.log(jnp.maximum(f, FORGET_FLOOR))
        key = (1.0 - lb) * jax.nn.sigmoid(-zf)
        return logf, key

    logf_f, k_f = gates(zf_fwd)
    logf_b, k_b = gates(zf_bwd)
    flip = lambda a: jnp.flip(a, axis=1)
    o_f = hgrn2_chunk_scan(q, logf_f, k_f, v)
    o_b = flip(hgrn2_chunk_scan(flip(q), flip(logf_b), flip(k_b), flip(v)))
    o = rms_norm(o_f + o_b, norm_gain) * jax.nn.silu(heads(zg, C_VAL_DIM))
    return o.reshape(B, S, C_WIDTH).astype(zq.dtype)


def setup_inputs(seed: int = 0) -> dict:
    key = jax.random.key(seed)
    ks = jax.random.split(key, 14)
    nrm = jax.random.normal
    f32 = jnp.float32
    return {
        "x": nrm(ks[0], (BATCH, SEQ, D_MODEL), f32),
        "c": nrm(ks[1], (BATCH, D_MODEL), f32),
        "w_mod": nrm(ks[2], (DEPTH, D_MODEL, 6 * D_MODEL), f32) * (0.5 * D_MODEL ** -0.5),
        "b_mod": nrm(ks[3], (DEPTH, 6 * D_MODEL), f32) * 0.02,
        "w_in": nrm(ks[4], (DEPTH, D_MODEL, IN_TOTAL), f32) * (D_MODEL ** -0.5),
        "a_qk_norm": 1.0 + 0.02 * nrm(ks[5], (DEPTH, 2, HEAD_DIM), f32),
        "diff_lambda": 0.1 * nrm(ks[6], (DEPTH, 4, B_QK_DIM), f32),
        "diff_subln": 1.0 + 0.02 * nrm(ks[7], (DEPTH, HEAD_DIM), f32),
        "hgrn_lower_bounds": 0.1 * nrm(ks[8], (DEPTH, C_HEADS * C_KEY_DIM), f32),
        "hgrn_norm": 1.0 + 0.02 * nrm(ks[9], (DEPTH, C_VAL_DIM), f32),
        "w_out": nrm(ks[10], (DEPTH, MIX_WIDTH, D_MODEL), f32) * (MIX_WIDTH ** -0.5),
        "w_ff1": nrm(ks[11], (DEPTH, D_MODEL, D_FF), f32) * (D_MODEL ** -0.5),
        "w_ff2": nrm(ks[12], (DEPTH, D_FF, D_MODEL), f32) * (D_FF ** -0.5),
        "final_norm": 1.0 + 0.02 * nrm(ks[13], (D_MODEL,), f32),
    }


def reference(x, c, w_mod, b_mod, w_in, a_qk_norm, diff_lambda, diff_subln, hgrn_lower_bounds, hgrn_norm, w_out, w_ff1, w_ff2, final_norm):
    S = x.shape[1]
    rows = S // GRID_W
    t = jnp.arange(S)
    row = jnp.repeat(jnp.arange(rows), GRID_W)
    col = jnp.tile(jnp.arange(GRID_W), rows)
    ang_row = rope_angles(row, HEAD_DIM // 2)
    ang_col = rope_angles(col, HEAD_DIM // 2)
    ang_1d = rope_angles(t, B_QK_DIM)

    lbp = jax.nn.softmax(hgrn_lower_bounds.astype(jnp.float32), axis=0)
    lbs = jnp.clip(jnp.cumsum(lbp, axis=0) - lbp[0:1], 0.0, 1.0)

    split_idx = [int(i) for i in np.cumsum(IN_SIZES)[:-1]]
    cond = jax.nn.silu(c)
    for l in range(DEPTH):
        mod = cond @ w_mod[l] + b_mod[l]
        sh1, sc1, g1, sh2, sc2, g2 = [m[:, None, :] for m in jnp.split(mod, 6, axis=-1)]

        h = rms_norm(x) * (1.0 + sc1) + sh1
        z = h @ w_in[l]
        aq, ak, av, bq, bk, bv, cq, cff, cfb, ci, cg = jnp.split(z, split_idx, axis=-1)
        o_a = mixer_axial_gqa(aq, ak, av, a_qk_norm[l], ang_row, ang_col)
        lam_init = 0.8 - 0.6 * math.exp(-0.3 * l)
        o_b = mixer_diff_attention(bq, bk, bv, diff_lambda[l], diff_subln[l], lam_init, ang_1d)
        o_c = mixer_hgrn2(cq, cff, cfb, ci, cg, lbs[l], hgrn_norm[l])
        x = x + g1 * (jnp.concatenate([o_a, o_b, o_c], axis=-1) @ w_out[l])

        h = rms_norm(x) * (1.0 + sc2) + sh2
        x = x + g2 * (jnp.square(jax.nn.relu(h @ w_ff1[l])) @ w_ff2[l])
    return rms_norm(x, final_norm)
```

```cpp
#include <hip/hip_runtime.h>
#include <hip/hip_cooperative_groups.h>
#include <hip/hip_bf16.h>
#include <cstdio>
#include <cstdint>
#include <cmath>
namespace cg = cooperative_groups;
namespace pg8 {
#define PG8_LAS __attribute__((address_space(3)))
typedef unsigned short bf16_t;
typedef short bf16x8 __attribute__((ext_vector_type(8)));
typedef float f32x4 __attribute__((ext_vector_type(4)));
typedef unsigned u32x4 __attribute__((ext_vector_type(4)));
constexpr int BM = 256, BK = 64, HALF = 128, HTB = HALF * BK * 2  , STAGE_BYTES = 8 * HTB, NXCD = 8, WGM = 8;

__host__ __device__ __forceinline__ int lds_byte(int r, int c) { const int st = (r >> 4) * 2 + (c >> 5), rr = r & 15, cc = c & 31, ob = rr * 64 + cc * 2; return st * 1024 + (ob ^ (((ob >> 9) & 1) << 5)); }
__host__ __device__ __forceinline__ void stage_rc(int b, int& R, int& C) { const int st = b / 1024, sb = b % 1024, swz = sb ^ (((sb >> 9) & 1) << 5); R = (st >> 1) * 16 + swz / 64; C = (st & 1) * 32 + (swz % 64) / 2; }
__host__ __device__ __forceinline__ int perm32(int rho) { const int n = rho >> 4, i = rho & 15; return 8 * (i >> 2) + 4 * n + (i & 3); }

struct Unit { int pm, pn; };
struct Gemm { const bf16_t* A; const bf16_t* Bt; int M, N, K; };

struct StaticOrder {
    int nM, nN, nwg, G, c;
    __host__ __device__ void init(int M, int N, int G_, int c_) { nM = M / BM; nN = N / BM; nwg = nM * nN; G = G_; c = c_; }
    __host__ __device__ bool next(int i, Unit& u) const {
        const long L = (long)i * G + c; if (L >= nwg) return false;
        int wgid = (int)L; { const int q = nwg / NXCD, r = nwg % NXCD, xcd = wgid % NXCD, off = wgid / NXCD; wgid = (xcd < r ? xcd * (q + 1) : r * (q + 1) + (xcd - r) * q) + off; }
        const int nig = WGM * nN, gid = wgid / nig, fm = gid * WGM, gsz = (nM - fm) < WGM ? (nM - fm) : WGM;
        u.pm = fm + ((wgid % nig) % gsz); u.pn = (wgid % nig) / gsz; return true;
    }
    __device__ __forceinline__ void a_ready(const Unit&) const {}
    __device__ __forceinline__ void done(const Unit&) const {}
};

__device__ __forceinline__ unsigned cvt_pk_bf16(float lo, float hi) { unsigned r; asm volatile("v_cvt_pk_bf16_f32 %0, %1, %2" : "=v"(r) : "v"(lo), "v"(hi)); return r; }
template <int ACT> struct EpiBf16 {
    static constexpr bool PERM = true, AFTER_DRAIN = false;
    bf16_t* O; int ldc;
    __device__ __forceinline__ void operator()(const f32x4 (&acc)[2][2][4][2], const Unit& u, int wr, int wc, int fr, int fq) const {
        const int row0 = u.pm * BM + wr * 64 + fr; const int col0 = u.pn * BM + wc * 32 + 8 * fq;
#pragma unroll
        for (int ai = 0; ai < 2; ++ai)
#pragma unroll
            for (int m = 0; m < 4; ++m) { bf16_t* rowp = O + (size_t)(row0 + ai * HALF + m * 16) * ldc + col0;
#pragma unroll
                for (int bj = 0; bj < 2; ++bj) { f32x4 v0 = acc[ai][bj][m][0], v1 = acc[ai][bj][m][1];
                    if (ACT == 2) {
#pragma unroll
                        for (int e = 0; e < 4; ++e) { const float a = fmaxf(v0[e], 0.f), b = fmaxf(v1[e], 0.f); v0[e] = a * a; v1[e] = b * b; } }
                    u32x4 w; w.x = cvt_pk_bf16(v0[0], v0[1]); w.y = cvt_pk_bf16(v0[2], v0[3]); w.z = cvt_pk_bf16(v1[0], v1[1]); w.w = cvt_pk_bf16(v1[2], v1[3]);
                    *(u32x4*)(rowp + bj * HALF) = w; } }
    }
};
struct EpiResGate {
    static constexpr bool PERM = false, AFTER_DRAIN = false;
    const float* xin; float* out; const float* gate;
    __device__ __forceinline__ void operator()(const f32x4 (&acc)[2][2][4][2], const Unit& u, int wr, int wc, int fr, int fq) const {
        const int b = (u.pm * BM) >> 11; const int col0 = u.pn * BM + wc * 32 + 4 * fq;
        f32x4 gv[2][2];
#pragma unroll
        for (int bj = 0; bj < 2; ++bj)
#pragma unroll
            for (int n = 0; n < 2; ++n) gv[bj][n] = *(const f32x4*)(gate + (size_t)b * 6144 + col0 + bj * HALF + n * 16);
#pragma unroll
        for (int ai = 0; ai < 2; ++ai)
#pragma unroll
            for (int m = 0; m < 4; ++m) { const size_t off = (size_t)(u.pm * BM + ai * HALF + wr * 64 + m * 16 + fr) * 1024 + col0;
#pragma unroll
                for (int bj = 0; bj < 2; ++bj)
#pragma unroll
                    for (int n = 0; n < 2; ++n) { const f32x4 xv = *(const f32x4*)(xin + off + bj * HALF + n * 16);
                        *(f32x4*)(out + off + bj * HALF + n * 16) = xv + gv[bj][n] * acc[ai][bj][m][n]; }
                asm volatile("" ::: "memory"); }
    }
};
template <class Epi, class Sched, bool ALIGN_EPI = false, bool SP2 = false>
__device__ __forceinline__ void gemm_phase(PG8_LAS unsigned char* lds, const Gemm g, const Sched& S, const Epi& E) {
    int tid_ = threadIdx.x; asm volatile("" : "+v"(tid_));
    const int tid = tid_, wid = __builtin_amdgcn_readfirstlane(tid >> 6), lane = tid & 63, wr = wid >> 2, wc = wid & 3, fr = lane & 15, fq = lane >> 4;
    const int K = g.K, nt = K / BK;
    unsigned voffA[2], voffB[2];
#pragma unroll
    for (int i = 0; i < 2; ++i) { int R, C; stage_rc(tid * 16 + i * 8192, R, C); const int Rb = Epi::PERM ? ((R & ~31) + perm32(R & 31)) : R;
        voffA[i] = (unsigned)(R * K + C) * 2u; voffB[i] = (unsigned)(Rb * K + C) * 2u; }
    const size_t kstep = (size_t)(BK * 2);
    const size_t hstep = (size_t)HALF * K * 2;
    const size_t tstep = 2 * hstep;
    const unsigned ldsw = (unsigned)wid * 1024u;
    const int aoff = lds_byte(wr * 64 + fr, fq * 8), boff = lds_byte(wc * 32 + fr, fq * 8);
#define PG8_SA(b, h) (((b) * 2 + (h)) * HTB)
#define PG8_SB(b, h) ((4 + (b) * 2 + (h)) * HTB)
#define PG8_STAGE(bufoff, gbase, voff) do { _Pragma("unroll") for (int _i = 0; _i < 2; ++_i) \
        __builtin_amdgcn_global_load_lds((const unsigned*)((const char*)(gbase) + (voff)[_i]), (PG8_LAS unsigned*)(lds + (bufoff) + ldsw + _i * 8192), 16, 0, 0); } while (0)
#define PG8_LDA(dst, b, h) do { _Pragma("unroll") for (int m = 0; m < 4; ++m) _Pragma("unroll") for (int k = 0; k < 2; ++k) dst[m][k] = *(const PG8_LAS bf16x8*)(lds + PG8_SA(b, h) + aoff + m * 2048 + k * 1024); } while (0)
#define PG8_LDB(dst, b, h) do { _Pragma("unroll") for (int n = 0; n < 2; ++n) _Pragma("unroll") for (int k = 0; k < 2; ++k) dst[n][k] = *(const PG8_LAS bf16x8*)(lds + PG8_SB(b, h) + boff + n * 2048 + k * 1024); } while (0)
#define PG8_MMA(ai, bj, At, Bt) do { __builtin_amdgcn_s_setprio(1); _Pragma("unroll") for (int m = 0; m < 4; ++m) _Pragma("unroll") for (int n = 0; n < 2; ++n) _Pragma("unroll") for (int k = 0; k < 2; ++k) \
        acc[ai][bj][m][n] = __builtin_amdgcn_mfma_f32_16x16x32_bf16(Bt[n][k], At[m][k], acc[ai][bj][m][n], 0, 0, 0); __builtin_amdgcn_s_setprio(0); } while (0)
#define PG8_WAIT_V(n) asm volatile("s_waitcnt vmcnt(" #n ")" ::: "memory")
#define PG8_WAIT_L(n) asm volatile("s_waitcnt lgkmcnt(" #n ")" ::: "memory")
#define PG8_BAR __builtin_amdgcn_s_barrier()
#define PG8_SCHED __builtin_amdgcn_sched_barrier(0)
    Unit cur, nxt; int ui = 0;
    if (!S.next(0, cur)) return;
    f32x4 acc[2][2][4][2];
#pragma unroll
    for (int a = 0; a < 2; ++a)
#pragma unroll
        for (int b = 0; b < 2; ++b)
#pragma unroll
            for (int m = 0; m < 4; ++m)
#pragma unroll
                for (int n = 0; n < 2; ++n) acc[a][b][m][n] = (f32x4){0.f, 0.f, 0.f, 0.f};
    bf16x8 At[4][2], B0[2][2], B1[2][2];
    const char* cA = (const char*)g.A + (size_t)cur.pm * tstep; const char* cB = (const char*)g.Bt + (size_t)cur.pn * tstep;
    S.a_ready(cur);
    if constexpr (SP2) {
        PG8_STAGE(PG8_SB(0, 0), cB, voffB); PG8_STAGE(PG8_SB(0, 1), cB + hstep, voffB); PG8_STAGE(PG8_SA(0, 0), cA, voffA); PG8_STAGE(PG8_SA(0, 1), cA + hstep, voffA);
        if (wr == 1) PG8_BAR;
        PG8_WAIT_V(2); PG8_BAR;
        PG8_STAGE(PG8_SB(1, 0), cB + kstep, voffB); PG8_STAGE(PG8_SA(1, 0), cA + kstep, voffA); PG8_STAGE(PG8_SB(1, 1), cB + hstep + kstep, voffB);
        PG8_WAIT_V(6); PG8_BAR;
    } else {
        PG8_STAGE(PG8_SB(0, 0), cB, voffB); PG8_STAGE(PG8_SA(0, 0), cA, voffA); PG8_STAGE(PG8_SB(0, 1), cB + hstep, voffB); PG8_STAGE(PG8_SA(0, 1), cA + hstep, voffA);
        if (wr == 1) PG8_BAR;
        PG8_WAIT_V(4); PG8_BAR;
        PG8_STAGE(PG8_SB(1, 0), cB + kstep, voffB); PG8_STAGE(PG8_SA(1, 0), cA + kstep, voffA); PG8_STAGE(PG8_SB(1, 1), cB + hstep + kstep, voffB);
        PG8_WAIT_V(6); PG8_BAR;
    }
    for (;;) {
        const bool has_next = S.next(ui + 1, nxt);
        const char* nA = has_next ? (const char*)g.A + (size_t)nxt.pm * tstep : cA; const char* nB = has_next ? (const char*)g.Bt + (size_t)nxt.pn * tstep : cB;
        for (int t = 0; t < nt; t += 2) {
            const bool last = (t == nt - 2);
            const char* a1 = cA + (size_t)(t + 1) * kstep;
            const char* a2 = last ? nA : cA + (size_t)(t + 2) * kstep; const char* b2 = last ? nB : cB + (size_t)(t + 2) * kstep;
            const char* a3 = a2 + kstep; const char* b3 = b2 + kstep;
            if (last && has_next) S.a_ready(nxt);
            if constexpr (SP2) {
            PG8_LDB(B0, 0, 0); PG8_LDB(B1, 0, 1); PG8_SCHED; PG8_LDA(At, 0, 0); PG8_STAGE(PG8_SA(1, 1), a1 + hstep, voffA);
            PG8_WAIT_V(8); PG8_WAIT_L(0); PG8_BAR; PG8_MMA(0, 0, At, B0); PG8_MMA(0, 1, At, B1); PG8_BAR; PG8_SCHED;
            PG8_LDA(At, 0, 1); PG8_STAGE(PG8_SB(0, 0), b2, voffB); PG8_STAGE(PG8_SB(0, 1), b2 + hstep, voffB); PG8_STAGE(PG8_SA(0, 0), a2, voffA);
            PG8_WAIT_V(8); PG8_WAIT_L(0); PG8_BAR; PG8_MMA(1, 0, At, B0); PG8_MMA(1, 1, At, B1); PG8_BAR; PG8_SCHED;
            PG8_LDB(B0, 1, 0); PG8_LDB(B1, 1, 1); PG8_SCHED; PG8_LDA(At, 1, 0); PG8_STAGE(PG8_SA(0, 1), a2 + hstep, voffA);
            PG8_WAIT_V(8); PG8_WAIT_L(0); PG8_BAR; PG8_MMA(0, 0, At, B0); PG8_MMA(0, 1, At, B1); PG8_BAR; PG8_SCHED;
            PG8_LDA(At, 1, 1); PG8_STAGE(PG8_SB(1, 0), b3, voffB); PG8_STAGE(PG8_SB(1, 1), b3 + hstep, voffB); PG8_STAGE(PG8_SA(1, 0), a3, voffA);
            PG8_WAIT_V(8); PG8_WAIT_L(0); PG8_BAR; PG8_MMA(1, 0, At, B0); PG8_MMA(1, 1, At, B1); PG8_BAR; PG8_SCHED;
            } else {
            PG8_LDB(B0, 0, 0); PG8_SCHED; PG8_LDA(At, 0, 0); PG8_STAGE(PG8_SA(1, 1), a1 + hstep, voffA);
            PG8_WAIT_L(8); PG8_BAR; PG8_WAIT_L(0); PG8_MMA(0, 0, At, B0); PG8_BAR; PG8_SCHED;
            PG8_LDB(B1, 0, 1); PG8_STAGE(PG8_SB(0, 0), b2, voffB);
            PG8_BAR; PG8_WAIT_L(0); PG8_MMA(0, 1, At, B1); PG8_BAR;
            PG8_LDA(At, 0, 1); PG8_STAGE(PG8_SA(0, 0), a2, voffA);
            PG8_BAR; PG8_WAIT_L(0); PG8_MMA(1, 0, At, B0); PG8_BAR; PG8_SCHED;
            PG8_STAGE(PG8_SB(0, 1), b2 + hstep, voffB);
            PG8_WAIT_V(6); PG8_BAR; PG8_MMA(1, 1, At, B1); PG8_BAR;
            PG8_LDB(B0, 1, 0); PG8_SCHED; PG8_LDA(At, 1, 0); PG8_STAGE(PG8_SA(0, 1), a2 + hstep, voffA);
            PG8_WAIT_L(8); PG8_BAR; PG8_WAIT_L(0); PG8_MMA(0, 0, At, B0); PG8_BAR; PG8_SCHED;
            PG8_LDB(B1, 1, 1); PG8_STAGE(PG8_SB(1, 0), b3, voffB);
            PG8_BAR; PG8_WAIT_L(0); PG8_MMA(0, 1, At, B1); PG8_BAR;
            PG8_LDA(At, 1, 1); PG8_STAGE(PG8_SA(1, 0), a3, voffA);
            PG8_BAR; PG8_WAIT_L(0); PG8_MMA(1, 0, At, B0); PG8_BAR; PG8_SCHED;
            PG8_STAGE(PG8_SB(1, 1), b3 + hstep, voffB);
            PG8_WAIT_V(6); PG8_BAR; PG8_MMA(1, 1, At, B1); PG8_BAR;
            }
        }
        if constexpr (ALIGN_EPI) { if (wr == 0) PG8_BAR; }
        if constexpr (!Epi::AFTER_DRAIN) { E(acc, cur, wr, wc, fr, fq); S.done(cur); }
        if (!has_next) break;
#pragma unroll
        for (int a = 0; a < 2; ++a)
#pragma unroll
            for (int b = 0; b < 2; ++b)
#pragma unroll
                for (int m = 0; m < 4; ++m)
#pragma unroll
                    for (int n = 0; n < 2; ++n) acc[a][b][m][n] = (f32x4){0.f, 0.f, 0.f, 0.f};
        cur = nxt; cA = nA; cB = nB; ++ui;
        if constexpr (ALIGN_EPI) { if (wr == 1) PG8_BAR; }
    }
    PG8_WAIT_V(0);
    if constexpr (!ALIGN_EPI) { if (wr == 0) PG8_BAR; }
    PG8_BAR;
    if constexpr (Epi::AFTER_DRAIN) { E.fused(acc, cur, wr, wc, fr, fq, lds, wid, lane); S.done(cur); }
#undef PG8_SA
#undef PG8_SB
#undef PG8_STAGE
#undef PG8_LDA
#undef PG8_LDB
#undef PG8_MMA
#undef PG8_WAIT_V
#undef PG8_WAIT_L
#undef PG8_BAR
#undef PG8_SCHED
}
}

#ifndef PG8_SP2
#define PG8_SP2 true
#endif
#ifndef PG8_ALIGN
#define PG8_ALIGN true
#endif
#include <hip/hip_bf16.h>
#include <cmath>
namespace attn_body {
using bf16=__hip_bfloat16;
using bf16x8=__attribute__((ext_vector_type(8)))short;
using s16x4=__attribute__((ext_vector_type(4)))short;
using f32x16=__attribute__((ext_vector_type(16)))float;
using u32x4=__attribute__((ext_vector_type(4)))unsigned;
constexpr int SEQ=2048,D=64;
constexpr int NW=8,QBLK=32,QB=QBLK*NW,KVBLK=64,NQB=SEQ/QB;
__device__ __forceinline__ int crow(int r,int hi){return (r&3)+8*(r>>2)+4*hi;}
#define SBAR() __builtin_amdgcn_sched_barrier(0)
constexpr int NSLOT=3, SLOTB=8192;
constexpr int LDS_K=0, LDS_V=NSLOT*SLOTB, LDS_WS=2*NSLOT*SLOTB, LDS_OST=LDS_WS+NW*64*4, LDS_STASH=LDS_OST+NW*4096, LDS_BYTES=LDS_STASH+NW*8192;
constexpr float LOG2E=1.4426950408889634f;
__device__ __forceinline__ void glds16(const void*gsrc,unsigned lds_dst){unsigned keep;
  asm volatile("s_mov_b32 %0, m0\n\ts_mov_b32 m0, %2\n\ts_nop 0\n\tglobal_load_lds_dwordx4 %1, off\n\ts_mov_b32 m0, %0":"=&s"(keep):"v"(gsrc),"s"(lds_dst):"memory");}
__device__ __forceinline__ float max3f(float a,float b,float c){float r;asm("v_max3_f32 %0, %1, %2, %3":"=v"(r):"v"(a),"v"(b),"v"(c));return r;}
__device__ __forceinline__ float max2f(float a,float b){float r;asm("v_max_f32_e32 %0, %1, %2":"=v"(r):"v"(a),"v"(b));return r;}
__device__ __forceinline__ float fadd_s(float a,float b){float r;asm("v_add_f32_e32 %0, %1, %2":"=v"(r):"v"(a),"v"(b));return r;}
__device__ __forceinline__ float fsub_s(float a,float b){float r;asm("v_sub_f32_e32 %0, %1, %2":"=v"(r):"v"(a),"v"(b));return r;}
typedef float f32x2_t __attribute__((ext_vector_type(2))); typedef __bf16 bf16x2_t __attribute__((ext_vector_type(2)));
__device__ __forceinline__ unsigned cvtpk_s(float lo,float hi){f32x2_t v={lo,hi};bf16x2_t b=__builtin_convertvector(v,bf16x2_t);return __builtin_bit_cast(unsigned,b);}
#define WAIT_BAR(N) asm volatile("s_waitcnt vmcnt(" #N ") lgkmcnt(0)\n\ts_barrier":::"memory")

__device__ __forceinline__ void qkt(f32x16&p0,f32x16&p1,const char*Kslot,const bf16x8*qr,const f32x16&negm,int r32,int hi){
  const char*kb=Kslot+hi*1024+r32*16;
  #pragma unroll
  for(int d0=0;d0<4;++d0){
    const bf16x8 b0=*reinterpret_cast<const bf16x8*>(kb+d0*2048);
    const bf16x8 b1=*reinterpret_cast<const bf16x8*>(kb+d0*2048+512);
    if(d0==0){p0=__builtin_amdgcn_mfma_f32_32x32x16_bf16(b0,qr[0],negm,0,0,0);p1=__builtin_amdgcn_mfma_f32_32x32x16_bf16(b1,qr[0],negm,0,0,0);}
    else{p0=__builtin_amdgcn_mfma_f32_32x32x16_bf16(b0,qr[d0],p0,0,0,0);p1=__builtin_amdgcn_mfma_f32_32x32x16_bf16(b1,qr[d0],p1,0,0,0);}}
}
typedef __attribute__((address_space(3))) const char* lds_cptr;
typedef short v4i16_t __attribute__((ext_vector_type(4)));
__device__ __forceinline__ void kload8(bf16x8*kf,lds_cptr kp){
  kf[0]=*(const __attribute__((address_space(3))) bf16x8*)(kp);      kf[1]=*(const __attribute__((address_space(3))) bf16x8*)(kp+512);
  kf[2]=*(const __attribute__((address_space(3))) bf16x8*)(kp+2048); kf[3]=*(const __attribute__((address_space(3))) bf16x8*)(kp+2560);
  kf[4]=*(const __attribute__((address_space(3))) bf16x8*)(kp+4096); kf[5]=*(const __attribute__((address_space(3))) bf16x8*)(kp+4608);
  kf[6]=*(const __attribute__((address_space(3))) bf16x8*)(kp+6144); kf[7]=*(const __attribute__((address_space(3))) bf16x8*)(kp+6656);
}
__device__ __forceinline__ void kload2(bf16x8*kf,lds_cptr kp,int j){ kf[2*j]=*(const __attribute__((address_space(3))) bf16x8*)(kp+j*2048); kf[2*j+1]=*(const __attribute__((address_space(3))) bf16x8*)(kp+j*2048+512); }
__device__ __forceinline__ s16x4 vtr(lds_cptr p){ return __builtin_bit_cast(s16x4,__builtin_amdgcn_ds_read_tr16_b64_v4i16((__attribute__((address_space(3))) v4i16_t*)p)); }
__device__ __forceinline__ float rowmax(const f32x16&p0,const f32x16&p1){
  float a=max3f(p0[0],p0[1],p1[0]),b=max3f(p0[2],p0[3],p1[1]);a=max3f(a,p1[2],p1[3]);
  #pragma unroll
  for(int r=4;r<16;r+=4){a=max3f(a,p0[r],p0[r+1]);b=max3f(b,p0[r+2],p0[r+3]);a=max3f(a,p1[r],p1[r+1]);b=max3f(b,p1[r+2],p1[r+3]);}
  const float m=max2f(a,b);
  auto rr=__builtin_amdgcn_permlane32_swap(__float_as_uint(m),__float_as_uint(m),false,false);
  return max2f(__uint_as_float(rr[0]),__uint_as_float(rr[1]));
}
__device__ __forceinline__ void pv(f32x16*o,int vb,bf16x8 pa0,bf16x8 pa1,bf16x8 pa2,bf16x8 pa3){
  #pragma unroll
  for(int d0=0;d0<2;++d0){s16x4 lo[4],hi[4];
    #pragma unroll
    for(int ks=0;ks<4;++ks){
      asm volatile("ds_read_b64_tr_b16 %0,%1 offset:%c2":"=&v"(lo[ks]):"v"(vb),"i"(d0*4096+ks*1024):"memory");
      asm volatile("ds_read_b64_tr_b16 %0,%1 offset:%c2":"=&v"(hi[ks]):"v"(vb),"i"(d0*4096+ks*1024+512):"memory");}
    asm volatile("s_waitcnt lgkmcnt(0)":::"memory");SBAR();
    #define PK(k) (bf16x8){lo[k][0],lo[k][1],lo[k][2],lo[k][3],hi[k][0],hi[k][1],hi[k][2],hi[k][3]}
    o[d0]=__builtin_amdgcn_mfma_f32_32x32x16_bf16(pa0,PK(0),o[d0],0,0,0);
    o[d0]=__builtin_amdgcn_mfma_f32_32x32x16_bf16(pa1,PK(1),o[d0],0,0,0);
    o[d0]=__builtin_amdgcn_mfma_f32_32x32x16_bf16(pa2,PK(2),o[d0],0,0,0);
    o[d0]=__builtin_amdgcn_mfma_f32_32x32x16_bf16(pa3,PK(3),o[d0],0,0,0);
    #undef PK
  }
}
struct AttnJob { const bf16* Q; int qp; const bf16* K; int kp; const bf16* V; int vp; bf16* O; int op; int npass; float lam; const float* gain; float oscale; };
typedef float f32x4a __attribute__((ext_vector_type(4)));
template<int THRL> __device__ __forceinline__ void attn_unit(const AttnJob& J,char*shm){
 for(int pass=0;pass<J.npass;++pass){
  int tid_=threadIdx.x; asm volatile("":"+v"(tid_)); const int tid=tid_,lane=tid&63,r32=lane&31,hi=lane>>5; const int wid=__builtin_amdgcn_readfirstlane(tid>>6);
  const bf16*Qw=J.Q+(long)(wid*QBLK)*J.qp+pass*64;
  const bf16*Kh=J.K,*Vh=J.V;
  const unsigned lds0=(unsigned)(uintptr_t)shm;
  float*wsf=(float*)(shm+LDS_WS)+wid*64;
  const bf16*ksrc=Kh+(long)lane*J.kp+wid*8;
  const bf16*vsrc=Vh+(long)(16*(wid&3)+(lane>>2))*J.vp+(wid>>2)*32+(lane&3)*8;
  const unsigned kdst=lds0+LDS_K+wid*1024, vdst=lds0+LDS_V+wid*1024;
  #define DMA_K(t,slot) glds16(ksrc+(long)(t)*KVBLK*J.kp,(unsigned)__builtin_amdgcn_readfirstlane(kdst+(slot)))
  #define DMA_V(t,slot) glds16(vsrc+(long)(t)*KVBLK*J.vp,(unsigned)__builtin_amdgcn_readfirstlane(vdst+(slot)))
  const int vb0=(int)(lds0+LDS_V)+((lane>>4)&1)*32+(lane&3)*8+(4*hi+((lane&15)>>2))*64;
  const char*Kbase=shm+LDS_K; bf16x8 kf[8];
  const lds_cptr shm3=(lds_cptr)shm; const lds_cptr kp0=shm3+LDS_K+hi*1024+r32*16; const lds_cptr vp0=shm3+LDS_V+((lane>>4)&1)*32+(lane&3)*8+(4*hi+((lane&15)>>2))*64;
  constexpr int NT=SEQ/KVBLK;
  DMA_K(0,0);DMA_V(0,0);DMA_K(1,SLOTB);
  bf16x8 qr[4];
  #pragma unroll
  for(int d0=0;d0<4;++d0)qr[d0]=*reinterpret_cast<const bf16x8*>(&Qw[(long)r32*J.qp+d0*16+hi*8]);
  float mhat=0.f,l_reg=0.f;f32x16 o[2];o[0]=f32x16{};o[1]=f32x16{};f32x16 negm=f32x16{};asm volatile("":"+v"(negm));
  #define CMASK(P0,P1,t) do{}while(0)
  bool resc=false;
  #define START(P0,P1) do{ const float rm=rowmax(P0,P1); resc=false; \
    { const float dl=rm; mhat=fadd_s(mhat,dl); \
      _Pragma("unroll") for(int r=0;r<16;++r){P0[r]=fsub_s(P0[r],dl);P1[r]=fsub_s(P1[r],dl);} \
      _Pragma("unroll") for(int r=0;r<16;++r)negm[r]=-mhat; asm volatile("":"+v"(negm)); } \
    _Pragma("unroll") for(int r=0;r<16;++r)P0[r]=__builtin_amdgcn_exp2f(P0[r]); }while(0)
  #define RESC() do{ if(resc){ asm volatile("s_waitcnt lgkmcnt(0)":::"memory"); \
      _Pragma("unroll") for(int d_=0;d_<2;++d_) _Pragma("unroll") for(int r=0;r<16;++r)o[d_][r]*=wsf[crow(r,hi)]; } }while(0)
  f32x16 pA0,pA1,pB0,pB1;
  int sl_prev=0,sl_cur=0,sl_next=SLOTB;
  #define ROT() do{sl_prev=sl_cur;sl_cur=sl_next;sl_next=(sl_next==(NSLOT-1)*SLOTB)?0:sl_next+SLOTB;}while(0)
  DMA_K(2,2*SLOTB);
  WAIT_BAR(3);
  qkt(pA0,pA1,Kbase,qr,negm,r32,hi);asm volatile("s_nop 15\n\ts_nop 7":"+v"(pA0),"+v"(pA1));CMASK(pA0,pA1,0);
  START(pA0,pA1);
  _Pragma("unroll") for(int r=0;r<16;++r)pA1[r]=__builtin_amdgcn_exp2f(pA1[r]);
  WAIT_BAR(0);
  DMA_K(3,0);DMA_V(1,SLOTB);
  ROT();
  kload8(kf,kp0+sl_cur);
  WAIT_BAR(2);
  s16x4 vlo[8],vhi[8]; u32x4 pw0,pw1,pw2,pw3;
  #define PKW(P,B) cvtpk_s(P[B],P[B+1])
  #define PAF(k) __builtin_bit_cast(bf16x8,pw##k)
  #define VFR(i) (bf16x8){vlo[i][0],vlo[i][1],vlo[i][2],vlo[i][3],vhi[i][0],vhi[i][1],vhi[i][2],vhi[i][3]}
  #define PIN(x) asm volatile("":"+v"(x))
  #define MX3(a,b,c) __builtin_fmaxf(__builtin_fmaxf((a),(b)),(c))
  #define GAPA(MF,A0,A1,A2,A3,W0,W1,PW) do{ MF; sacc+=A0; sacc+=A1; sacc+=A2; sacc+=A3; PIN(sacc); W0; W1; PIN(PW); SBAR(); }while(0)
  #define EX(v) __builtin_amdgcn_exp2f(v)
  #define GAPB(MF,X,B) do{ MF; X[B]=EX(X[B]); X[B+1]=EX(X[B+1]); X[B+2]=EX(X[B+2]); X[B+3]=EX(X[B+3]); PIN(X); SBAR(); }while(0)
  #define VRD(i) do{ vlo[i]=vtr(vp_+(((i)>>2)*4096+((i)&3)*1024)); vhi[i]=vtr(vp_+(((i)>>2)*4096+((i)&3)*1024+512)); }while(0)
  #define KRD(G,j) do{ if(G){ kload2(kf,kp0+sl_next,j); SBAR(); } }while(0)
  #define STEP(C0,C1,P0,P1,t,GK,GV,GL) do{ SBAR(); \
    const lds_cptr vp_=vp0+sl_prev; \
    VRD(0); SBAR(); float sacc=(P0[0]+P0[1]); \
    GAPA(C0=__builtin_amdgcn_mfma_f32_32x32x16_bf16(kf[0],qr[0],negm,0,0,0), P0[2],P0[3],P0[4],P0[5],     pw0[0]=PKW(P0,0), pw0[1]=PKW(P0,2), pw0); \
    VRD(4); SBAR(); GAPA(C1=__builtin_amdgcn_mfma_f32_32x32x16_bf16(kf[1],qr[0],negm,0,0,0), P0[6],P0[7],P0[8],P0[9],     pw0[2]=PKW(P0,4), pw0[3]=PKW(P0,6), pw0); \
    VRD(1); SBAR(); GAPA(C0=__builtin_amdgcn_mfma_f32_32x32x16_bf16(kf[2],qr[1],C0,0,0,0),   P0[10],P0[11],P0[12],P0[13], pw1[0]=PKW(P0,8), pw1[1]=PKW(P0,10), pw1); \
    VRD(5); SBAR(); GAPA(C1=__builtin_amdgcn_mfma_f32_32x32x16_bf16(kf[3],qr[1],C1,0,0,0),   P0[14],P0[15],P1[0],P1[1],   pw1[2]=PKW(P0,12),pw1[3]=PKW(P0,14), pw1); \
    VRD(2); SBAR(); GAPA(C0=__builtin_amdgcn_mfma_f32_32x32x16_bf16(kf[4],qr[2],C0,0,0,0),   P1[2],P1[3],P1[4],P1[5],     pw2[0]=PKW(P1,0), pw2[1]=PKW(P1,2), pw2); \
    VRD(6); SBAR(); GAPA(C1=__builtin_amdgcn_mfma_f32_32x32x16_bf16(kf[5],qr[2],C1,0,0,0),   P1[6],P1[7],P1[8],P1[9],     pw2[2]=PKW(P1,4), pw2[3]=PKW(P1,6), pw2); \
    VRD(3); SBAR(); GAPA(C0=__builtin_amdgcn_mfma_f32_32x32x16_bf16(kf[6],qr[3],C0,0,0,0),   P1[10],P1[11],P1[12],P1[13], pw3[0]=PKW(P1,8), pw3[1]=PKW(P1,10), pw3); \
    VRD(7); SBAR(); GAPA(C1=__builtin_amdgcn_mfma_f32_32x32x16_bf16(kf[7],qr[3],C1,0,0,0),   P1[14],P1[15],0.f,0.f,       pw3[2]=PKW(P1,12),pw3[3]=PKW(P1,14), pw3); \
    l_reg+=sacc; \
    if(GK){DMA_K((t)+3,sl_cur);} if(GV){DMA_V((t)+1,sl_next);} \
    CMASK(C0,C1,t); \
    { float a=MX3(C0[0],C0[1],C1[0]),b=MX3(C0[2],C0[3],C1[1]); a=MX3(a,C1[2],C1[3]); \
      _Pragma("unroll") for(int r=4;r<16;r+=4){a=MX3(a,C0[r],C0[r+1]);b=MX3(b,C0[r+2],C0[r+3]);a=MX3(a,C1[r],C1[r+1]);b=MX3(b,C1[r+2],C1[r+3]);} \
      float rm=__builtin_fmaxf(a,b); { auto rr=__builtin_amdgcn_permlane32_swap(__float_as_uint(rm),__float_as_uint(rm),false,false); rm=__builtin_fmaxf(__uint_as_float(rr[0]),__uint_as_float(rr[1])); } \
      resc=false; \
      if(__builtin_expect(__any(rm>(float)THRL),0)){ const float dl=__builtin_fmaxf(rm,0.f); mhat+=dl; \
        _Pragma("unroll") for(int r=0;r<16;++r){C0[r]-=dl;C1[r]-=dl;} \
        _Pragma("unroll") for(int r=0;r<16;++r)negm[r]=-mhat; asm volatile("":"+v"(negm)); \
        const float f=__builtin_amdgcn_exp2f(-dl); l_reg*=f; if(hi==0)wsf[r32]=f; resc=true; } } \
    SBAR(); \
    GAPB(o[0]=__builtin_amdgcn_mfma_f32_32x32x16_bf16(PAF(0),VFR(0),o[0],0,0,0), C0,0); \
    GAPB(o[1]=__builtin_amdgcn_mfma_f32_32x32x16_bf16(PAF(0),VFR(4),o[1],0,0,0), C0,4); \
    KRD(GL,0); GAPB(o[0]=__builtin_amdgcn_mfma_f32_32x32x16_bf16(PAF(1),VFR(1),o[0],0,0,0), C0,8); \
    KRD(GL,1); GAPB(o[1]=__builtin_amdgcn_mfma_f32_32x32x16_bf16(PAF(1),VFR(5),o[1],0,0,0), C0,12); \
    KRD(GL,2); GAPB(o[0]=__builtin_amdgcn_mfma_f32_32x32x16_bf16(PAF(2),VFR(2),o[0],0,0,0), C1,0); \
    KRD(GL,3); GAPB(o[1]=__builtin_amdgcn_mfma_f32_32x32x16_bf16(PAF(2),VFR(6),o[1],0,0,0), C1,4); \
    GAPB(o[0]=__builtin_amdgcn_mfma_f32_32x32x16_bf16(PAF(3),VFR(3),o[0],0,0,0), C1,8); \
    GAPB(o[1]=__builtin_amdgcn_mfma_f32_32x32x16_bf16(PAF(3),VFR(7),o[1],0,0,0), C1,12); \
    }while(0)
  int t=1;
  #undef CMASK
  #define CMASK(P0,P1,t) do{}while(0)
  for(;t+5<NT;t+=2){
    STEP(pB0,pB1,pA0,pA1,t,true,true,true);     WAIT_BAR(2); RESC(); ROT();
    STEP(pA0,pA1,pB0,pB1,t+1,true,true,true);   WAIT_BAR(2); RESC(); ROT();
  }
  #undef CMASK
  #define CMASK(P0,P1,t) do{}while(0)
  #define ENDW(tt) do{ if((tt)+3<NT){WAIT_BAR(2);} else if((tt)+2<NT){WAIT_BAR(1);} else {WAIT_BAR(0);} }while(0)
  for(;t+1<NT;t+=2){
    STEP(pB0,pB1,pA0,pA1,t,(t+3<NT),(t+1<NT),(t+1<NT));       ENDW(t);   RESC(); ROT();
    STEP(pA0,pA1,pB0,pB1,t+1,(t+4<NT),(t+2<NT),(t+2<NT));     ENDW(t+1); RESC(); ROT();
  }
  STEP(pB0,pB1,pA0,pA1,NT-1,false,false,false); RESC();
  { float sacc=pB0[0]+pB0[1]; _Pragma("unroll") for(int r=2;r<16;++r)sacc+=pB0[r]; _Pragma("unroll") for(int r=0;r<16;++r)sacc+=pB1[r]; l_reg+=sacc;
    pw0=(u32x4){PKW(pB0,0),PKW(pB0,2),PKW(pB0,4),PKW(pB0,6)};pw1=(u32x4){PKW(pB0,8),PKW(pB0,10),PKW(pB0,12),PKW(pB0,14)};pw2=(u32x4){PKW(pB1,0),PKW(pB1,2),PKW(pB1,4),PKW(pB1,6)};pw3=(u32x4){PKW(pB1,8),PKW(pB1,10),PKW(pB1,12),PKW(pB1,14)};
    SBAR(); pv(o,vb0+sl_cur,PAF(0),PAF(1),PAF(2),PAF(3)); }
  #undef PKW
  #undef PAF
  #undef VFR
  #undef PIN
  #undef MX3
  #undef GAPA
  #undef GAPB
  #undef EX
  #undef VRD
  #undef KRD
  #undef STEP
  #undef ENDW
  {auto rr=__builtin_amdgcn_permlane32_swap(__float_as_uint(l_reg),__float_as_uint(l_reg),false,false);l_reg=__uint_as_float(rr[0])+__uint_as_float(rr[1]);}
  if(hi==0)wsf[32+r32]=l_reg;asm volatile("s_waitcnt lgkmcnt(0)":::"memory");
  float rli[16];
  #pragma unroll
  for(int r=0;r<16;++r)rli[r]=__builtin_amdgcn_rcpf(wsf[32+crow(r,hi)]);
  bf16*Ow=J.O+(long)(wid*QBLK)*J.op;
  if(J.npass==1){ bf16*stg=(bf16*)(shm+LDS_OST)+wid*2048;
    #pragma unroll
    for(int r=0;r<16;++r){const int orow=crow(r,hi);
      #pragma unroll
      for(int d0=0;d0<2;++d0)stg[orow*64+d0*32+r32]=__float2bfloat16(o[d0][r]*rli[r]);}
    asm volatile("s_waitcnt lgkmcnt(0)":::"memory");
    #pragma unroll
    for(int i=0;i<4;++i){const int row=i*8+(lane>>3),ch=lane&7; const u32x4 v=*(const u32x4*)(stg+row*64+ch*8); *(u32x4*)(Ow+(long)row*J.op+ch*8)=v;} }
  else { float*st=(float*)(shm+LDS_STASH)+wid*2048;
    if(pass==0){
      #pragma unroll
      for(int r=0;r<16;++r){
        #pragma unroll
        for(int d0=0;d0<2;++d0)st[(r*2+d0)*64+lane]=o[d0][r]*rli[r];}
    } else {
      float dv[2][16];
      #pragma unroll
      for(int r=0;r<16;++r){
        #pragma unroll
        for(int d0=0;d0<2;++d0)dv[d0][r]=st[(r*2+d0)*64+lane]-J.lam*(o[d0][r]*rli[r]);}
      asm volatile("s_waitcnt lgkmcnt(0)":::"memory");
      #pragma unroll
      for(int r=0;r<16;++r){const int orow=crow(r,hi);
        #pragma unroll
        for(int d0=0;d0<2;++d0)st[orow*64+d0*32+r32]=dv[d0][r];}
      asm volatile("s_waitcnt lgkmcnt(0)":::"memory");
      #pragma unroll
      for(int i=0;i<4;++i){const int row=i*8+(lane>>3),ch=lane&7;
        const f32x4a a=*(const f32x4a*)(st+row*64+ch*8), b2=*(const f32x4a*)(st+row*64+ch*8+4);
        float ss=(a[0]*a[0]+a[1]*a[1])+(a[2]*a[2]+a[3]*a[3])+(b2[0]*b2[0]+b2[1]*b2[1])+(b2[2]*b2[2]+b2[3]*b2[3]);
        ss+=__shfl_xor(ss,1);ss+=__shfl_xor(ss,2);ss+=__shfl_xor(ss,4);
        const float rs=rsqrtf(ss*(1.0f/64.0f)+1e-6f)*J.oscale;
        const f32x4a g0=*(const f32x4a*)(J.gain+ch*8), g1=*(const f32x4a*)(J.gain+ch*8+4);
        u32x4 v; v[0]=cvtpk_s(a[0]*rs*g0[0],a[1]*rs*g0[1]); v[1]=cvtpk_s(a[2]*rs*g0[2],a[3]*rs*g0[3]); v[2]=cvtpk_s(b2[0]*rs*g1[0],b2[1]*rs*g1[1]); v[3]=cvtpk_s(b2[2]*rs*g1[2],b2[3]*rs*g1[3]);
        *(u32x4*)(Ow+(long)row*J.op+ch*8)=v;}
    } }
  asm volatile("s_waitcnt lgkmcnt(0)\n\ts_barrier":::"memory");
  #undef DMA_K
  #undef DMA_V
  #undef CMASK
  #undef START
  #undef RESC
  #undef ROT
 }
}
constexpr int ATTN_LDS_BYTES=LDS_BYTES;
#undef SBAR
#undef WAIT_BAR
}
#define LAS __attribute__((address_space(3)))
typedef unsigned short bfu;
typedef unsigned v4u __attribute__((ext_vector_type(4)));
typedef unsigned v2u __attribute__((ext_vector_type(2)));
typedef float f32x4 __attribute__((ext_vector_type(4)));
typedef short bf16x8 __attribute__((ext_vector_type(8)));
constexpr int NWAVES = 8, NTHR = 512;
constexpr int BATCH = 32, SEQ = 2048, DM = 1024, M = BATCH * SEQ, NIN = 3072, DFF = 4096, NMOD = 6144;
constexpr size_t MiB = 1u << 20;
constexpr size_t WS_CTL = 0, CTL_ZERO_BYTES = 4096;
constexpr size_t WS_MOD = 1 * MiB;
constexpr size_t WS_ROPE = 3 * MiB;
constexpr size_t WS_WIN = 4 * MiB, WS_WOUT = 16 * MiB, WS_WFF1 = 20 * MiB, WS_WFF2 = 36 * MiB;
constexpr size_t WS_HN = 64 * MiB;
constexpr size_t WS_MIX = 192 * MiB;
constexpr size_t WS_OF = 320 * MiB;
constexpr size_t WS_Z = 384 * MiB;
constexpr size_t WS_QA = 768 * MiB, WS_KA = 816 * MiB, WS_QB = 832 * MiB, WS_KB = 928 * MiB;
constexpr size_t WS_HID = 384 * MiB;
constexpr size_t WS_END = 976 * MiB;
constexpr int LDS_TOTAL = 149504;
static_assert(attn_body::ATTN_LDS_BYTES <= LDS_TOTAL && pg8::STAGE_BYTES <= LDS_TOTAL, "lds");

struct Params {
    const float *x, *c, *w_mod, *b_mod, *w_in, *a_qk_norm, *diff_lambda, *diff_subln, *hgrn_lb, *hgrn_norm, *w_out, *w_ff1, *w_ff2, *final_norm;
    float* out; unsigned char* ws;
};

__device__ __forceinline__ float bf2f(unsigned short u) { return __uint_as_float((unsigned)u << 16); }
__device__ __forceinline__ unsigned pkbf(float lo, float hi) { typedef float f2 __attribute__((ext_vector_type(2))); typedef __bf16 b2 __attribute__((ext_vector_type(2))); f2 v = {lo, hi}; b2 b = __builtin_convertvector(v, b2); return __builtin_bit_cast(unsigned, b); }
__device__ __forceinline__ unsigned short f2bf1(float x) { return (unsigned short)(pkbf(x, 0.f) & 0xffffu); }
__device__ __forceinline__ float wave_sum(float v) {
#pragma unroll
    for (int o = 1; o < 64; o <<= 1) v += __shfl_xor(v, o);
    return v;
}
__device__ __forceinline__ float sigmoidf_(float x) { return 1.0f / (1.0f + __expf(-x)); }

__device__ __forceinline__ void p0_transpose_item(const float* W, int K, int N, bfu* WT, LAS float* scr, int item, int lane) {
    const int nblk = N / 32, kb = item / nblk, nb = item % nblk, k0 = 64 * kb, n0 = 32 * nb;
#pragma unroll 8
    for (int i = 0; i < 32; ++i) { const int kk = 2 * i + (lane >> 5); scr[kk * 33 + (lane & 31)] = W[(size_t)(k0 + kk) * N + n0 + (lane & 31)]; }
    asm volatile("s_waitcnt lgkmcnt(0)" ::: "memory");
    const int c = lane & 7;
#pragma unroll
    for (int j = 0; j < 4; ++j) { const int n = (lane >> 3) + 8 * j; const LAS float* s = scr + (8 * c) * 33 + n;
        v4u o; o.x = pkbf(s[0 * 33], s[1 * 33]); o.y = pkbf(s[2 * 33], s[3 * 33]); o.z = pkbf(s[4 * 33], s[5 * 33]); o.w = pkbf(s[6 * 33], s[7 * 33]);
        *(v4u*)(WT + (size_t)(n0 + n) * K + k0 + 8 * c) = o; }
    asm volatile("s_waitcnt lgkmcnt(0)" ::: "memory");
}

__device__ __forceinline__ void phase_prologue(const Params& p, LAS unsigned char* lds, int tid, int lane, int wave) {
    const int G = gridDim.x;
    float* MOD = (float*)(p.ws + WS_MOD);
    LAS float* SC = (LAS float*)lds;
    for (int u = blockIdx.x; u < 2 * (NMOD / 64); u += G) {
        const int l = u / (NMOD / 64), cg0 = (u % (NMOD / 64)) * 64;
        for (int i = tid; i < BATCH * DM; i += NTHR) { const float cv = p.c[i]; SC[i] = cv * sigmoidf_(cv); }
        __syncthreads();
        float acc[32];
#pragma unroll
        for (int b = 0; b < 32; ++b) acc[b] = 0.f;
        const float* wp = p.w_mod + ((size_t)l * DM + wave * 128) * NMOD + cg0 + lane;
        for (int k4 = 0; k4 < 128; k4 += 4) {
            const float w0 = wp[(size_t)(k4 + 0) * NMOD], w1 = wp[(size_t)(k4 + 1) * NMOD], w2 = wp[(size_t)(k4 + 2) * NMOD], w3 = wp[(size_t)(k4 + 3) * NMOD];
#pragma unroll
            for (int b = 0; b < 32; ++b) { const f32x4 s = *(const LAS f32x4*)(SC + b * DM + wave * 128 + k4); acc[b] += s[0] * w0 + s[1] * w1 + s[2] * w2 + s[3] * w3; }
        }
        __syncthreads();
        LAS float* RED = (LAS float*)lds;
#pragma unroll
        for (int b = 0; b < 32; ++b) RED[(wave * 32 + b) * 64 + lane] = acc[b];
        __syncthreads();
#pragma unroll
        for (int bb = 0; bb < 4; ++bb) { const int b = wave * 4 + bb; float s = 0.f;
#pragma unroll
            for (int w = 0; w < 8; ++w) s += RED[(w * 32 + b) * 64 + lane];
            MOD[((size_t)l * BATCH + b) * NMOD + cg0 + lane] = s + p.b_mod[l * NMOD + cg0 + lane]; }
        __syncthreads();
    }
    {
        float* ROPE = (float*)(p.ws + WS_ROPE);
        for (int i = blockIdx.x * NTHR + tid; i < 2048 * 16; i += G * NTHR) {
            const int pos = i >> 4, j = i & 15;
            const double inv = exp2(-(double)j * (13.287712379549449 / 16.0));
            const double rev = (double)pos * inv * 0.15915494309189535;
            const float fr = (float)(rev - floor(rev));
            ROPE[2 * i] = __builtin_amdgcn_cosf(fr); ROPE[2 * i + 1] = __builtin_amdgcn_sinf(fr);
        }
    }
    {
        LAS float* scr = (LAS float*)(lds + wave * 16384);
        const int gw = blockIdx.x * NWAVES + wave, NGW = G * NWAVES;
        constexpr int I_IN = (DM / 64) * (NIN / 32), I_OUT = (DM / 64) * (DM / 32), I_F1 = (DM / 64) * (DFF / 32), I_F2 = (DFF / 64) * (DM / 32);
        constexpr int PER_L = I_IN + I_OUT + I_F1 + I_F2;
        for (int it = gw; it < 2 * PER_L; it += NGW) {
            const int l = it / PER_L; int r = it % PER_L;
            if (r < I_IN) { p0_transpose_item(p.w_in + (size_t)l * DM * NIN, DM, NIN, (bfu*)(p.ws + WS_WIN) + (size_t)l * NIN * DM, scr, r, lane); continue; } r -= I_IN;
            if (r < I_OUT) { p0_transpose_item(p.w_out + (size_t)l * DM * DM, DM, DM, (bfu*)(p.ws + WS_WOUT) + (size_t)l * DM * DM, scr, r, lane); continue; } r -= I_OUT;
            if (r < I_F1) { p0_transpose_item(p.w_ff1 + (size_t)l * DM * DFF, DM, DFF, (bfu*)(p.ws + WS_WFF1) + (size_t)l * DFF * DM, scr, r, lane); continue; } r -= I_F1;
            p0_transpose_item(p.w_ff2 + (size_t)l * DFF * DM, DFF, DM, (bfu*)(p.ws + WS_WFF2) + (size_t)l * DM * DFF, scr, r, lane);
        }
    }
}

__device__ __forceinline__ void phase_modnorm(const float* xin, const float* modl  , int off_sh, int off_sc, bfu* HN, int lane, int wave) {
    const int gw = blockIdx.x * NWAVES + wave, NGW = gridDim.x * NWAVES;
    for (int m = gw; m < M; m += NGW) {
        const f32x4* xr = (const f32x4*)(xin + (size_t)m * DM) + lane;
        const float* mb = modl + (size_t)(m >> 11) * NMOD;
        f32x4 v[4]; float s = 0.f;
#pragma unroll
        for (int j = 0; j < 4; ++j) { v[j] = xr[64 * j]; s += (v[j][0] * v[j][0] + v[j][1] * v[j][1]) + (v[j][2] * v[j][2] + v[j][3] * v[j][3]); }
        const float rs = rsqrtf(wave_sum(s) * (1.f / DM) + 1e-6f);
        unsigned long long* o8 = (unsigned long long*)(HN + (size_t)m * DM) + lane;
#pragma unroll
        for (int j = 0; j < 4; ++j) { const f32x4 sc = *((const f32x4*)(mb + off_sc) + lane + 64 * j), sh = *((const f32x4*)(mb + off_sh) + lane + 64 * j);
            const f32x4 y = v[j] * rs * (sc + 1.0f) + sh;
            o8[64 * j] = (unsigned long long)pkbf(y[0], y[1]) | ((unsigned long long)pkbf(y[2], y[3]) << 32); }
    }
}
__device__ __forceinline__ void phase_finalnorm(float* x, const float* gain, int lane, int wave) {
    const int gw = blockIdx.x * NWAVES + wave, NGW = gridDim.x * NWAVES;
    for (int m = gw; m < M; m += NGW) {
        f32x4* xr = (f32x4*)(x + (size_t)m * DM) + lane;
        f32x4 v[4]; float s = 0.f;
#pragma unroll
        for (int j = 0; j < 4; ++j) { v[j] = xr[64 * j]; s += (v[j][0] * v[j][0] + v[j][1] * v[j][1]) + (v[j][2] * v[j][2] + v[j][3] * v[j][3]); }
        const float rs = rsqrtf(wave_sum(s) * (1.f / DM) + 1e-6f);
#pragma unroll
        for (int j = 0; j < 4; ++j) { const f32x4 g = *((const f32x4*)gain + lane + 64 * j); xr[64 * j] = v[j] * rs * g; }
    }
}

__device__ __forceinline__ void unpack8(const v4u r, float (&v)[8]) {
#pragma unroll
    for (int i = 0; i < 4; ++i) { v[2 * i] = __uint_as_float(r[i] << 16); v[2 * i + 1] = __uint_as_float(r[i] & 0xffff0000u); }
}
__device__ __forceinline__ v4u pack8(const float (&v)[8]) { v4u o; o[0] = pkbf(v[0], v[1]); o[1] = pkbf(v[2], v[3]); o[2] = pkbf(v[4], v[5]); o[3] = pkbf(v[6], v[7]); return o; }
__device__ __forceinline__ void rope8(float (&v)[8], const float* tab, bool second) {
    float pv[8];
#pragma unroll
    for (int k = 0; k < 8; ++k) pv[k] = __shfl_xor(v[k], 2);
#pragma unroll
    for (int k4 = 0; k4 < 4; ++k4) { const f32x4 cs = *(const f32x4*)(tab + 4 * k4);
        const int k = 2 * k4;
        v[k] = second ? v[k] * cs[0] + pv[k] * cs[1] : v[k] * cs[0] - pv[k] * cs[1];
        v[k + 1] = second ? v[k + 1] * cs[2] + pv[k + 1] * cs[3] : v[k + 1] * cs[2] - pv[k + 1] * cs[3]; }
}
__device__ __forceinline__ void phase_post(const Params& p, int l, int lane, int wave) {
    const bfu* Z = (const bfu*)(p.ws + WS_Z); const float* ROPE = (const float*)(p.ws + WS_ROPE);
    bfu* QA = (bfu*)(p.ws + WS_QA); bfu* KA = (bfu*)(p.ws + WS_KA); bfu* QB = (bfu*)(p.ws + WS_QB); bfu* KB = (bfu*)(p.ws + WS_KB);
    const float C2A = 0.125f * attn_body::LOG2E, C2B = 0.17677669529663687f * attn_body::LOG2E;
    const int gw = blockIdx.x * NWAVES + wave, NGW = gridDim.x * NWAVES;
    for (int m = gw; m < M; m += NGW) {
        const int s = m & 2047, prow = s >> 6, pcol = s & 63;
        const bfu* zr = Z + (size_t)m * NIN;
        {
            const int head = lane >> 3, ch = lane & 7;
            float v[8]; unpack8(*(const v4u*)(zr + head * 64 + ch * 8), v);
            float ss = 0.f;
#pragma unroll
            for (int k = 0; k < 8; ++k) ss += v[k] * v[k];
            ss += __shfl_xor(ss, 1); ss += __shfl_xor(ss, 2); ss += __shfl_xor(ss, 4);
            const float rs = rsqrtf(ss * (1.f / 64.f) + 1e-6f);
            const float* gp = p.a_qk_norm + l * 128 + (head < 6 ? 0 : 64) + ch * 8;
            const f32x4 g0 = *(const f32x4*)gp, g1 = *(const f32x4*)(gp + 4);
#pragma unroll
            for (int k = 0; k < 4; ++k) { v[k] *= rs * g0[k]; v[k + 4] *= rs * g1[k]; }
            const int pos = (ch & 4) ? pcol : prow;
            rope8(v, ROPE + (pos * 16 + 8 * (ch & 1)) * 2, (ch & 2) != 0);
            if (head < 6) {
#pragma unroll
                for (int k = 0; k < 8; ++k) v[k] *= C2A;
                *(v4u*)(QA + (size_t)m * 384 + head * 64 + ch * 8) = pack8(v);
            } else *(v4u*)(KA + (size_t)m * 128 + (head - 6) * 64 + ch * 8) = pack8(v);
        }
        {
            const bool act = lane < 48; const int ln = act ? lane : lane - 48;
            const int hc = ln >> 2, ch = ln & 3;
            const float* tab = ROPE + (s * 16 + 8 * (ch & 1)) * 2;
            float v[8]; unpack8(*(const v4u*)(zr + 640 + hc * 32 + ch * 8), v);
            rope8(v, tab, (ch & 2) != 0);
#pragma unroll
            for (int k = 0; k < 8; ++k) v[k] *= C2B;
            if (act) { const int comp = hc & 1; bfu* qd = QB + (size_t)m * 768 + hc * 64;
                *(v4u*)(qd + comp * 32 + ch * 8) = pack8(v); *(v4u*)(qd + (1 - comp) * 32 + ch * 8) = (v4u){0u, 0u, 0u, 0u}; }
            unpack8(*(const v4u*)(zr + 1024 + hc * 32 + ch * 8), v);
            rope8(v, tab, (ch & 2) != 0);
            if (act) *(v4u*)(KB + (size_t)m * 384 + hc * 32 + ch * 8) = pack8(v);
        }
    }
}
namespace hg {
constexpr int PB = 144;
constexpr int QE = 0, QC = 9216, KV = 18432, KLT = 55296, VT = 64512, ST = 73728, PP = 82944, TOT = 92160, AA = 94208, OO = 94464, LDS_BYTES = OO + 64 * 68 * 4;
static_assert(LDS_BYTES <= LDS_TOTAL, "hgrn lds");
#define HG_MFMA(a, b, c) __builtin_amdgcn_mfma_f32_16x16x32_bf16(a, b, c, 0, 0, 0)
#define HG_LD8(off) (*(const LAS bf16x8*)(L + (off)))
__device__ __forceinline__ void hgrn_unit(LAS unsigned char* L, const Params& p, int layer, int b, int h) {
    int tid_ = threadIdx.x; asm volatile("" : "+v"(tid_));
    const int tid = tid_, lane = tid & 63, g = __builtin_amdgcn_readfirstlane(tid >> 6), fr = lane & 15, fq = lane >> 4;
    const bfu* Z = (const bfu*)(p.ws + WS_Z); float* OF = (float*)(p.ws + WS_OF); bfu* MIX = (bfu*)(p.ws + WS_MIX);
    const int d = lane;
    float lb = 0.f;
    if (layer == 1) { const float b0 = p.hgrn_lb[h * 64 + d], b1 = p.hgrn_lb[256 + h * 64 + d]; lb = fminf(fmaxf(1.0f / (1.0f + __expf(b0 - b1)), 0.f), 1.f); }
    const float oml = 1.0f - lb;
    const int I = g >> 1, jh = g & 1;
    const float* gain = p.hgrn_norm + layer * 64;
    for (int dir = 0; dir < 2; ++dir) {
        __syncthreads();
        for (int i = tid; i < 64 * PB / 4; i += NTHR) ((LAS unsigned*)(L + ST))[i] = 0u;
        f32x4 Sreg[2]; Sreg[0] = (f32x4){0.f, 0.f, 0.f, 0.f}; Sreg[1] = Sreg[0];
        const int fcol = (dir ? 2304 : 2048) + h * 64 + d;
        for (int c = 0; c < 32; ++c) {
            const int tb = dir ? (2047 - 64 * c) : 64 * c, ts = dir ? -1 : 1;
            float bl[8], qv[8], kk[8]; unsigned short vb[8]; float run = 0.f;
#pragma unroll
            for (int j = 0; j < 8; ++j) {
                const size_t row = (size_t)b * SEQ + (tb + ts * (8 * g + j));
                const bfu* zr = Z + row * NIN;
                const float zq = bf2f(zr[1792 + h * 64 + d]); float zf = bf2f(zr[fcol]); vb[j] = zr[2560 + h * 64 + d];
                zf = fminf(fmaxf(zf, -30.f), 30.f);
                const float e = __expf(-zf), sig = 1.0f / (1.0f + e), sgn = e * sig;
                const float f = lb + oml * sig;
                run += __logf(fmaxf(f, 1e-6f)); bl[j] = run; kk[j] = oml * sgn;
                qv[j] = zq * sigmoidf_(zq) * 0.125f;
            }
            ((LAS float*)(L + TOT))[g * 64 + d] = run;
            __syncthreads();
            float prefix = 0.f, R0 = 0.f, R1 = 0.f, R2 = 0.f, R3 = 0.f, blast;
            { float pp = 0.f;
#pragma unroll
              for (int g2 = 0; g2 < 8; ++g2) { if (g2 == g) prefix = pp; if (g2 == 2) R1 = pp; if (g2 == 4) R2 = pp; if (g2 == 6) R3 = pp; pp += ((const LAS float*)(L + TOT))[g2 * 64 + d]; }
              blast = pp; }
            const float RI = I == 0 ? R0 : (I == 1 ? R1 : (I == 2 ? R2 : R3));
            unsigned klp[4], vp[4];
#pragma unroll
            for (int j = 0; j < 8; ++j) {
                const int t = 8 * g + j; const float bc = prefix + bl[j];
                *(LAS unsigned short*)(L + QE + t * PB + d * 2) = f2bf1(qv[j] * __expf(bc - RI));
                *(LAS unsigned short*)(L + QC + t * PB + d * 2) = f2bf1(qv[j] * __expf(bc));
                if (I <= 0) *(LAS unsigned short*)(L + KV + 0 * 9216 + t * PB + d * 2) = f2bf1(kk[j] * __expf(fminf(R0 - bc, 80.f)));
                if (I <= 1) *(LAS unsigned short*)(L + KV + 1 * 9216 + t * PB + d * 2) = f2bf1(kk[j] * __expf(fminf(R1 - bc, 80.f)));
                if (I <= 2) *(LAS unsigned short*)(L + KV + 2 * 9216 + t * PB + d * 2) = f2bf1(kk[j] * __expf(fminf(R2 - bc, 80.f)));
                *(LAS unsigned short*)(L + KV + 3 * 9216 + t * PB + d * 2) = f2bf1(kk[j] * __expf(fminf(R3 - bc, 80.f)));
                bl[j] = kk[j] * __expf(blast - bc);
            }
#pragma unroll
            for (int j = 0; j < 4; ++j) { klp[j] = pkbf(bl[2 * j], bl[2 * j + 1]); vp[j] = (unsigned)vb[2 * j] | ((unsigned)vb[2 * j + 1] << 16); }
            *(LAS v4u*)(L + KLT + d * PB + g * 16) = (v4u){klp[0], klp[1], klp[2], klp[3]};
            *(LAS v4u*)(L + VT + d * PB + g * 16) = (v4u){vp[0], vp[1], vp[2], vp[3]};
            if (g == 0) ((LAS float*)(L + AA))[d] = __expf(blast);
            __syncthreads();
#pragma unroll
            for (int jj = 0; jj < 2; ++jj) { const int Jb = 2 * jh + jj;
                f32x4 acc = (f32x4){0.f, 0.f, 0.f, 0.f};
                if (Jb <= I) {
#pragma unroll
                    for (int k2 = 0; k2 < 2; ++k2) acc = HG_MFMA(HG_LD8(QE + (16 * I + fr) * PB + (k2 * 32 + 8 * fq) * 2), HG_LD8(KV + I * 9216 + (16 * Jb + fr) * PB + (k2 * 32 + 8 * fq) * 2), acc);
                }
#pragma unroll
                for (int i = 0; i < 4; ++i) { const float val = (Jb < I || (Jb == I && fr <= 4 * fq + i)) ? acc[i] : 0.f;
                    *(LAS unsigned short*)(L + PP + (16 * I + 4 * fq + i) * PB + (16 * Jb + fr) * 2) = f2bf1(val); }
            }
            __syncthreads();
            const f32x4 a4 = *(const LAS f32x4*)(L + AA + (16 * I + 4 * fq) * 4);
#pragma unroll
            for (int nn = 0; nn < 2; ++nn) { const int n = 2 * jh + nn;
                f32x4 acc = (f32x4){0.f, 0.f, 0.f, 0.f};
#pragma unroll
                for (int k2 = 0; k2 < 2; ++k2) acc = HG_MFMA(HG_LD8(PP + (16 * I + fr) * PB + (k2 * 32 + 8 * fq) * 2), HG_LD8(VT + (16 * n + fr) * PB + (k2 * 32 + 8 * fq) * 2), acc);
#pragma unroll
                for (int k2 = 0; k2 < 2; ++k2) acc = HG_MFMA(HG_LD8(QC + (16 * I + fr) * PB + (k2 * 32 + 8 * fq) * 2), HG_LD8(ST + (16 * n + fr) * PB + (k2 * 32 + 8 * fq) * 2), acc);
#pragma unroll
                for (int i = 0; i < 4; ++i) ((LAS float*)(L + OO))[(16 * I + 4 * fq + i) * 68 + 16 * n + fr] = acc[i];
                f32x4 sr = Sreg[nn] * a4;
#pragma unroll
                for (int k2 = 0; k2 < 2; ++k2) sr = HG_MFMA(HG_LD8(KLT + (16 * I + fr) * PB + (k2 * 32 + 8 * fq) * 2), HG_LD8(VT + (16 * n + fr) * PB + (k2 * 32 + 8 * fq) * 2), sr);
                Sreg[nn] = sr;
            }
            __syncthreads();
#pragma unroll
            for (int nn = 0; nn < 2; ++nn) { const int n = 2 * jh + nn;
                *(LAS v2u*)(L + ST + (16 * n + fr) * PB + (16 * I + 4 * fq) * 2) = (v2u){pkbf(Sreg[nn][0], Sreg[nn][1]), pkbf(Sreg[nn][2], Sreg[nn][3])}; }
            {
                const int t = tid >> 3, j8 = tid & 7;
                const f32x4 o0 = *(const LAS f32x4*)(L + OO + (t * 68 + 8 * j8) * 4), o1 = *(const LAS f32x4*)(L + OO + (t * 68 + 8 * j8 + 4) * 4);
                const size_t row = (size_t)b * SEQ + (tb + ts * t);
                float* ofp = OF + row * 256 + h * 64 + 8 * j8;
                if (dir == 0) { *(f32x4*)ofp = o0; *(f32x4*)(ofp + 4) = o1; }
                else {
                    float sv[8];
#pragma unroll
                    for (int k = 0; k < 4; ++k) { const unsigned long long w = __hip_atomic_load((const unsigned long long*)ofp + k, __ATOMIC_RELAXED, __HIP_MEMORY_SCOPE_AGENT);
                        sv[2 * k] = __uint_as_float((unsigned)w); sv[2 * k + 1] = __uint_as_float((unsigned)(w >> 32)); }
#pragma unroll
                    for (int k = 0; k < 4; ++k) { sv[k] += o0[k]; sv[k + 4] += o1[k]; }
                    float ss = 0.f;
#pragma unroll
                    for (int k = 0; k < 8; ++k) ss += sv[k] * sv[k];
                    ss += __shfl_xor(ss, 1); ss += __shfl_xor(ss, 2); ss += __shfl_xor(ss, 4);
                    const float rs = rsqrtf(ss * (1.f / 64.f) + 1e-6f);
                    float zg[8]; unpack8(*(const v4u*)(Z + row * NIN + 2816 + h * 64 + 8 * j8), zg);
                    const f32x4 g0 = *(const f32x4*)(gain + 8 * j8), g1 = *(const f32x4*)(gain + 8 * j8 + 4);
#pragma unroll
                    for (int k = 0; k < 4; ++k) { sv[k] = sv[k] * rs * g0[k] * (zg[k] * sigmoidf_(zg[k])); sv[k + 4] = sv[k + 4] * rs * g1[k] * (zg[k + 4] * sigmoidf_(zg[k + 4])); }
                    *(v4u*)(MIX + row * DM + 768 + h * 64 + 8 * j8) = pack8(sv);
                }
            }
        }
    }
    __syncthreads();
}
#undef HG_MFMA
#undef HG_LD8
}
__device__ __forceinline__ void phase_mixer(const Params& p, int l, LAS unsigned char* lds, unsigned* ctr) {
    using attn_body::bf16;
    int tid = threadIdx.x; asm volatile("" : "+v"(tid));
    const bf16* Z = (const bf16*)(p.ws + WS_Z); bf16* MIX = (bf16*)(p.ws + WS_MIX);
    const bf16* QA = (const bf16*)(p.ws + WS_QA); const bf16* KA = (const bf16*)(p.ws + WS_KA); const bf16* QB = (const bf16*)(p.ws + WS_QB); const bf16* KB = (const bf16*)(p.ws + WS_KB);
    float lam;
    { const float* lp = p.diff_lambda + l * 128; float s1 = 0.f, s2 = 0.f;
      for (int i = 0; i < 32; ++i) { s1 += lp[i] * lp[32 + i]; s2 += lp[64 + i] * lp[96 + i]; }
      const float lam_init = (l == 0) ? 0.2f : (0.8f - 0.6f * 0.7408182206817179f);
      lam = expf(s1) - expf(s2) + lam_init; }
    const float lam_init = (l == 0) ? 0.2f : (0.8f - 0.6f * 0.7408182206817179f);
    constexpr int N_H = BATCH * 4, N_B = BATCH * 6 * 8, N_A = BATCH * 6 * 8, N_ITEMS = N_H + N_B + N_A;
    LAS int* nxt = (LAS int*)(lds + LDS_TOTAL - 16);
    int item = blockIdx.x;
    while (item < N_ITEMS) {
        if (item < N_H) hg::hgrn_unit(lds, p, l, item >> 2, item & 3);
        else {
            attn_body::AttnJob J;
            if (item < N_H + N_B) { const int u = item - N_H, b = u / 48, h = (u % 48) >> 3, qb = u & 7; const size_t r0 = (size_t)b * SEQ, rq = r0 + qb * 256;
                J.Q = QB + rq * 768 + h * 128; J.qp = 768; J.K = KB + r0 * 384 + h * 64; J.kp = 384; J.V = Z + r0 * NIN + 1408 + h * 64; J.vp = NIN;
                J.O = MIX + rq * DM + 384 + h * 64; J.op = DM; J.npass = 2; J.lam = lam; J.gain = p.diff_subln + l * 64; J.oscale = 1.0f - lam_init; }
            else { const int u = item - N_H - N_B, b = u / 48, r = u % 48, kvh = r / 24, gq = (r % 24) >> 3, qb = r & 7, head = kvh * 3 + gq; const size_t r0 = (size_t)b * SEQ, rq = r0 + qb * 256;
                J.Q = QA + rq * 384 + head * 64; J.qp = 384; J.K = KA + r0 * 128 + kvh * 64; J.kp = 128; J.V = Z + r0 * NIN + 512 + kvh * 64; J.vp = NIN;
                J.O = MIX + rq * DM + head * 64; J.op = DM; J.npass = 1; J.lam = 0.f; J.gain = p.diff_subln; J.oscale = 1.f; }
            attn_body::attn_unit<8>(J, (char*)lds);
        }
        if (tid == 0) *nxt = (int)atomicAdd(ctr, 1u) + (int)gridDim.x;
        __syncthreads();
        item = *nxt;
        __syncthreads();
    }
}

typedef const __attribute__((address_space(4))) Params* KParams;
__device__ __forceinline__ Params ldp() {
#if defined(__HIP_DEVICE_COMPILE__)
    KParams k = (KParams)__builtin_amdgcn_kernarg_segment_ptr(); asm volatile("" : "+s"(k)); Params r;
    r.x = k->x; r.c = k->c; r.w_mod = k->w_mod; r.b_mod = k->b_mod; r.w_in = k->w_in; r.a_qk_norm = k->a_qk_norm; r.diff_lambda = k->diff_lambda; r.diff_subln = k->diff_subln; r.hgrn_lb = k->hgrn_lb;
    r.hgrn_norm = k->hgrn_norm; r.w_out = k->w_out; r.w_ff1 = k->w_ff1; r.w_ff2 = k->w_ff2; r.final_norm = k->final_norm; r.out = k->out; r.ws = k->ws; return r;
#else
    return Params{};
#endif
}
__global__ void __launch_bounds__(NTHR, 2) fwd_megakernel(Params p_unused) {
    extern __shared__ __attribute__((aligned(16))) unsigned char lds_raw[];
    LAS unsigned char* lds = (LAS unsigned char*)lds_raw;
    cg::grid_group grid = cg::this_grid();
    { int tid = threadIdx.x; asm volatile("" : "+v"(tid)); const int lane = tid & 63, wave = __builtin_amdgcn_readfirstlane(tid >> 6);
      const Params p = ldp(); phase_prologue(p, lds, tid, lane, wave); }
    grid.sync();
#pragma unroll 1
    for (int l = 0; l < 2; ++l) {
        { int tid = threadIdx.x; asm volatile("" : "+v"(tid)); const int lane = tid & 63, wave = __builtin_amdgcn_readfirstlane(tid >> 6);
          const Params p = ldp(); phase_modnorm((l == 0) ? p.x : p.out, (const float*)(p.ws + WS_MOD) + (size_t)l * BATCH * NMOD, 0, 1024, (bfu*)(p.ws + WS_HN), lane, wave); }
        grid.sync();
        {
            const Params p = ldp();
            pg8::Gemm g{(const bfu*)(p.ws + WS_HN), (const bfu*)(p.ws + WS_WIN) + (size_t)l * NIN * DM, M, NIN, DM}; pg8::StaticOrder S; S.init(M, NIN, (int)gridDim.x, (int)blockIdx.x);
            pg8::EpiBf16<0> E{(bfu*)(p.ws + WS_Z), NIN};
            pg8::gemm_phase<pg8::EpiBf16<0>, pg8::StaticOrder, PG8_ALIGN, PG8_SP2>(lds, g, S, E);
        }
        grid.sync();
        { int tid = threadIdx.x; asm volatile("" : "+v"(tid)); const int lane = tid & 63, wave = __builtin_amdgcn_readfirstlane(tid >> 6);
          const Params p = ldp(); phase_post(p, l, lane, wave); }
        grid.sync();
        { const Params p = ldp(); phase_mixer(p, l, lds, (unsigned*)(p.ws + WS_CTL) + 64 * l); }
        grid.sync();
        {
            const Params p = ldp();
            pg8::Gemm g{(const bfu*)(p.ws + WS_MIX), (const bfu*)(p.ws + WS_WOUT) + (size_t)l * DM * DM, M, DM, DM}; pg8::StaticOrder S; S.init(M, DM, (int)gridDim.x, (int)blockIdx.x);
            pg8::EpiResGate E{(l == 0) ? p.x : p.out, p.out, (const float*)(p.ws + WS_MOD) + (size_t)l * BATCH * NMOD + 2048};
            pg8::gemm_phase<pg8::EpiResGate, pg8::StaticOrder, PG8_ALIGN, PG8_SP2>(lds, g, S, E);
        }
        grid.sync();
        { int tid = threadIdx.x; asm volatile("" : "+v"(tid)); const int lane = tid & 63, wave = __builtin_amdgcn_readfirstlane(tid >> 6);
          const Params p = ldp(); phase_modnorm(p.out, (const float*)(p.ws + WS_MOD) + (size_t)l * BATCH * NMOD, 3072, 4096, (bfu*)(p.ws + WS_HN), lane, wave); }
        grid.sync();
        {
            const Params p = ldp();
            pg8::Gemm g{(const bfu*)(p.ws + WS_HN), (const bfu*)(p.ws + WS_WFF1) + (size_t)l * DFF * DM, M, DFF, DM}; pg8::StaticOrder S; S.init(M, DFF, (int)gridDim.x, (int)blockIdx.x);
            pg8::EpiBf16<2> E{(bfu*)(p.ws + WS_HID), DFF};
            pg8::gemm_phase<pg8::EpiBf16<2>, pg8::StaticOrder, PG8_ALIGN, PG8_SP2>(lds, g, S, E);
        }
        grid.sync();
        {
            const Params p = ldp();
            pg8::Gemm g{(const bfu*)(p.ws + WS_HID), (const bfu*)(p.ws + WS_WFF2) + (size_t)l * DM * DFF, M, DM, DFF}; pg8::StaticOrder S; S.init(M, DM, (int)gridDim.x, (int)blockIdx.x);
            pg8::EpiResGate E{p.out, p.out, (const float*)(p.ws + WS_MOD) + (size_t)l * BATCH * NMOD + 5120};
            pg8::gemm_phase<pg8::EpiResGate, pg8::StaticOrder, PG8_ALIGN, PG8_SP2>(lds, g, S, E);
        }
        grid.sync();
    }
    { int tid = threadIdx.x; asm volatile("" : "+v"(tid)); const int lane = tid & 63, wave = __builtin_amdgcn_readfirstlane(tid >> 6);
      const Params p = ldp(); phase_finalnorm(p.out, p.final_norm, lane, wave); }
}

extern "C" void kernel_launch(void* const* d_in, const int* in_sizes, int n_in, void* d_out, int out_size, void* d_ws, size_t ws_size, hipStream_t stream) {
    static int grid = 0;
    if (grid == 0) {
        if (n_in != 14 || in_sizes[0] != M * DM || out_size != M * DM || ws_size < WS_END) { fprintf(stderr, "kernel_launch: unexpected shapes (n_in %d in0 %d out %d ws %zu)\n", n_in, n_in > 0 ? in_sizes[0] : -1, out_size, ws_size); grid = -1; return; }
        int dev = 0, cus = 0, per_cu = 0;
        hipGetDevice(&dev); hipDeviceGetAttribute(&cus, hipDeviceAttributeMultiprocessorCount, dev);
        if (hipFuncSetAttribute((const void*)fwd_megakernel, hipFuncAttributeMaxDynamicSharedMemorySize, LDS_TOTAL) != hipSuccess) { fprintf(stderr, "kernel_launch: hipFuncSetAttribute failed\n"); grid = -1; return; }
        if (hipOccupancyMaxActiveBlocksPerMultiprocessor(&per_cu, (const void*)fwd_megakernel, NTHR, LDS_TOTAL) != hipSuccess || per_cu < 1) { fprintf(stderr, "kernel_launch: occupancy query says %d\n", per_cu); per_cu = 1; }
        (void)hipGetLastError();
        grid = cus * 1;
        (void)per_cu;
    }
    if (grid < 0) return;
    hipMemsetAsync((char*)d_ws + WS_CTL, 0, CTL_ZERO_BYTES, stream);
    Params p{};
    p.x = (const float*)d_in[0]; p.c = (const float*)d_in[1]; p.w_mod = (const float*)d_in[2]; p.b_mod = (const float*)d_in[3]; p.w_in = (const float*)d_in[4];
    p.a_qk_norm = (const float*)d_in[5]; p.diff_lambda = (const float*)d_in[6]; p.diff_subln = (const float*)d_in[7]; p.hgrn_lb = (const float*)d_in[8]; p.hgrn_norm = (const float*)d_in[9];
    p.w_out = (const float*)d_in[10]; p.w_ff1 = (const float*)d_in[11]; p.w_ff2 = (const float*)d_in[12]; p.final_norm = (const float*)d_in[13];
    p.out = (float*)d_out; p.ws = (unsigned char*)d_ws;
    void* args[] = {&p};
    hipError_t e = hipLaunchCooperativeKernel((const void*)fwd_megakernel, dim3(grid), dim3(NTHR), args, LDS_TOTAL, stream);
    if (e != hipSuccess) fprintf(stderr, "cooperative launch failed: %s (grid %d)\n", hipGetErrorString(e), grid);
}
```

```cpp
#include <hip/hip_runtime.h>
#include <hip/hip_cooperative_groups.h>
#include <hip/hip_bf16.h>
#include <cstdio>
#include <cstdint>
#include <cmath>
namespace cg = cooperative_groups;
namespace pg8 {
#define PG8_LAS __attribute__((address_space(3)))
typedef unsigned short bf16_t;
typedef short bf16x8 __attribute__((ext_vector_type(8)));
typedef float f32x4 __attribute__((ext_vector_type(4)));
typedef unsigned u32x4 __attribute__((ext_vector_type(4)));
constexpr int BM = 256, BK = 64, HALF = 128, HTB = HALF * BK * 2  , STAGE_BYTES = 8 * HTB, NXCD = 8, WGM = 8;

__host__ __device__ __forceinline__ int lds_byte(int r, int c) { const int st = (r >> 4) * 2 + (c >> 5), rr = r & 15, cc = c & 31, ob = rr * 64 + cc * 2; return st * 1024 + (ob ^ (((ob >> 9) & 1) << 5)); }
__host__ __device__ __forceinline__ void stage_rc(int b, int& R, int& C) { const int st = b / 1024, sb = b % 1024, swz = sb ^ (((sb >> 9) & 1) << 5); R = (st >> 1) * 16 + swz / 64; C = (st & 1) * 32 + (swz % 64) / 2; }
__host__ __device__ __forceinline__ int perm32(int rho) { const int n = rho >> 4, i = rho & 15; return 8 * (i >> 2) + 4 * n + (i & 3); }

struct Unit { int pm, pn; };
struct Gemm { const bf16_t* A; const bf16_t* Bt; int M, N, K; };

struct StaticOrder {
    int nM, nN, nwg, G, c;
    __host__ __device__ void init(int M, int N, int G_, int c_) { nM = M / BM; nN = N / BM; nwg = nM * nN; G = G_; c = c_; }
    __host__ __device__ bool next(int i, Unit& u) const {
        const long L = (long)i * G + c; if (L >= nwg) return false;
        int wgid = (int)L; { const int q = nwg / NXCD, r = nwg % NXCD, xcd = wgid % NXCD, off = wgid / NXCD; wgid = (xcd < r ? xcd * (q + 1) : r * (q + 1) + (xcd - r) * q) + off; }
        const int nig = WGM * nN, gid = wgid / nig, fm = gid * WGM, gsz = (nM - fm) < WGM ? (nM - fm) : WGM;
        u.pm = fm + ((wgid % nig) % gsz); u.pn = (wgid % nig) / gsz; return true;
    }
    __device__ __forceinline__ void a_ready(const Unit&) const {}
    __device__ __forceinline__ void done(const Unit&) const {}
};

__device__ __forceinline__ unsigned cvt_pk_bf16(float lo, float hi) { unsigned r; asm volatile("v_cvt_pk_bf16_f32 %0, %1, %2" : "=v"(r) : "v"(lo), "v"(hi)); return r; }
template <int ACT> struct EpiBf16 {
    static constexpr bool PERM = true, AFTER_DRAIN = false;
    bf16_t* O; int ldc;
    __device__ __forceinline__ void operator()(const f32x4 (&acc)[2][2][4][2], const Unit& u, int wr, int wc, int fr, int fq) const {
        const int row0 = u.pm * BM + wr * 64 + fr; const int col0 = u.pn * BM + wc * 32 + 8 * fq;
#pragma unroll
        for (int ai = 0; ai < 2; ++ai)
#pragma unroll
            for (int m = 0; m < 4; ++m) { bf16_t* rowp = O + (size_t)(row0 + ai * HALF + m * 16) * ldc + col0;
#pragma unroll
                for (int bj = 0; bj < 2; ++bj) { f32x4 v0 = acc[ai][bj][m][0], v1 = acc[ai][bj][m][1];
                    if (ACT == 2) {
#pragma unroll
                        for (int e = 0; e < 4; ++e) { const float a = fmaxf(v0[e], 0.f), b = fmaxf(v1[e], 0.f); v0[e] = a * a; v1[e] = b * b; } }
                    u32x4 w; w.x = cvt_pk_bf16(v0[0], v0[1]); w.y = cvt_pk_bf16(v0[2], v0[3]); w.z = cvt_pk_bf16(v1[0], v1[1]); w.w = cvt_pk_bf16(v1[2], v1[3]);
                    *(u32x4*)(rowp + bj * HALF) = w; } }
    }
};
struct EpiResGate {
    static constexpr bool PERM = false, AFTER_DRAIN = false;
    const float* xin; float* out; const float* gate;
    __device__ __forceinline__ void operator()(const f32x4 (&acc)[2][2][4][2], const Unit& u, int wr, int wc, int fr, int fq) const {
        const int b = (u.pm * BM) >> 11; const int col0 = u.pn * BM + wc * 32 + 4 * fq;
        f32x4 gv[2][2];
#pragma unroll
        for (int bj = 0; bj < 2; ++bj)
#pragma unroll
            for (int n = 0; n < 2; ++n) gv[bj][n] = *(const f32x4*)(gate + (size_t)b * 6144 + col0 + bj * HALF + n * 16);
#pragma unroll
        for (int ai = 0; ai < 2; ++ai)
#pragma unroll
            for (int m = 0; m < 4; ++m) { const size_t off = (size_t)(u.pm * BM + ai * HALF + wr * 64 + m * 16 + fr) * 1024 + col0;
#pragma unroll
                for (int bj = 0; bj < 2; ++bj)
#pragma unroll
                    for (int n = 0; n < 2; ++n) { const f32x4 xv = *(const f32x4*)(xin + off + bj * HALF + n * 16);
                        *(f32x4*)(out + off + bj * HALF + n * 16) = xv + gv[bj][n] * acc[ai][bj][m][n]; }
                asm volatile("" ::: "memory"); }
    }
};
template <class Epi, class Sched, bool ALIGN_EPI = false, bool SP2 = false>
__device__ __forceinline__ void gemm_phase(PG8_LAS unsigned char* lds, const Gemm g, const Sched& S, const Epi& E) {
    int tid_ = threadIdx.x; asm volatile("" : "+v"(tid_));
    const int tid = tid_, wid = __builtin_amdgcn_readfirstlane(tid >> 6), lane = tid & 63, wr = wid >> 2, wc = wid & 3, fr = lane & 15, fq = lane >> 4;
    const int K = g.K, nt = K / BK;
    unsigned voffA[2], voffB[2];
#pragma unroll
    for (int i = 0; i < 2; ++i) { int R, C; stage_rc(tid * 16 + i * 8192, R, C); const int Rb = Epi::PERM ? ((R & ~31) + perm32(R & 31)) : R;
        voffA[i] = (unsigned)(R * K + C) * 2u; voffB[i] = (unsigned)(Rb * K + C) * 2u; }
    const size_t kstep = (size_t)(BK * 2);
    const size_t hstep = (size_t)HALF * K * 2;
    const size_t tstep = 2 * hstep;
    const unsigned ldsw = (unsigned)wid * 1024u;
    const int aoff = lds_byte(wr * 64 + fr, fq * 8), boff = lds_byte(wc * 32 + fr, fq * 8);
#define PG8_SA(b, h) (((b) * 2 + (h)) * HTB)
#define PG8_SB(b, h) ((4 + (b) * 2 + (h)) * HTB)
#define PG8_STAGE(bufoff, gbase, voff) do { _Pragma("unroll") for (int _i = 0; _i < 2; ++_i) \
        __builtin_amdgcn_global_load_lds((const unsigned*)((const char*)(gbase) + (voff)[_i]), (PG8_LAS unsigned*)(lds + (bufoff) + ldsw + _i * 8192), 16, 0, 0); } while (0)
#define PG8_LDA(dst, b, h) do { _Pragma("unroll") for (int m = 0; m < 4; ++m) _Pragma("unroll") for (int k = 0; k < 2; ++k) dst[m][k] = *(const PG8_LAS bf16x8*)(lds + PG8_SA(b, h) + aoff + m * 2048 + k * 1024); } while (0)
#define PG8_LDB(dst, b, h) do { _Pragma("unroll") for (int n = 0; n < 2; ++n) _Pragma("unroll") for (int k = 0; k < 2; ++k) dst[n][k] = *(const PG8_LAS bf16x8*)(lds + PG8_SB(b, h) + boff + n * 2048 + k * 1024); } while (0)
#define PG8_MMA(ai, bj, At, Bt) do { __builtin_amdgcn_s_setprio(1); _Pragma("unroll") for (int m = 0; m < 4; ++m) _Pragma("unroll") for (int n = 0; n < 2; ++n) _Pragma("unroll") for (int k = 0; k < 2; ++k) \
        acc[ai][bj][m][n] = __builtin_amdgcn_mfma_f32_16x16x32_bf16(Bt[n][k], At[m][k], acc[ai][bj][m][n], 0, 0, 0); __builtin_amdgcn_s_setprio(0); } while (0)
#define PG8_WAIT_V(n) asm volatile("s_waitcnt vmcnt(" #n ")" ::: "memory")
#define PG8_WAIT_L(n) asm volatile("s_waitcnt lgkmcnt(" #n ")" ::: "memory")
#define PG8_BAR __builtin_amdgcn_s_barrier()
#define PG8_SCHED __builtin_amdgcn_sched_barrier(0)
    Unit cur, nxt; int ui = 0;
    if (!S.next(0, cur)) return;
    f32x4 acc[2][2][4][2];
#pragma unroll
    for (int a = 0; a < 2; ++a)
#pragma unroll
        for (int b = 0; b < 2; ++b)
#pragma unroll
            for (int m = 0; m < 4; ++m)
#pragma unroll
                for (int n = 0; n < 2; ++n) acc[a][b][m][n] = (f32x4){0.f, 0.f, 0.f, 0.f};
    bf16x8 At[4][2], B0[2][2], B1[2][2];
    const char* cA = (const char*)g.A + (size_t)cur.pm * tstep; const char* cB = (const char*)g.Bt + (size_t)cur.pn * tstep;
    S.a_ready(cur);
    if constexpr (SP2) {
        PG8_STAGE(PG8_SB(0, 0), cB, voffB); PG8_STAGE(PG8_SB(0, 1), cB + hstep, voffB); PG8_STAGE(PG8_SA(0, 0), cA, voffA); PG8_STAGE(PG8_SA(0, 1), cA + hstep, voffA);
        if (wr == 1) PG8_BAR;
        PG8_WAIT_V(2); PG8_BAR;
        PG8_STAGE(PG8_SB(1, 0), cB + kstep, voffB); PG8_STAGE(PG8_SA(1, 0), cA + kstep, voffA); PG8_STAGE(PG8_SB(1, 1), cB + hstep + kstep, voffB);
        PG8_WAIT_V(6); PG8_BAR;
    } else {
        PG8_STAGE(PG8_SB(0, 0), cB, voffB); PG8_STAGE(PG8_SA(0, 0), cA, voffA); PG8_STAGE(PG8_SB(0, 1), cB + hstep, voffB); PG8_STAGE(PG8_SA(0, 1), cA + hstep, voffA);
        if (wr == 1) PG8_BAR;
        PG8_WAIT_V(4); PG8_BAR;
        PG8_STAGE(PG8_SB(1, 0), cB + kstep, voffB); PG8_STAGE(PG8_SA(1, 0), cA + kstep, voffA); PG8_STAGE(PG8_SB(1, 1), cB + hstep + kstep, voffB);
        PG8_WAIT_V(6); PG8_BAR;
    }
    for (;;) {
        const bool has_next = S.next(ui + 1, nxt);
        const char* nA = has_next ? (const char*)g.A + (size_t)nxt.pm * tstep : cA; const char* nB = has_next ? (const char*)g.Bt + (size_t)nxt.pn * tstep : cB;
        for (int t = 0; t < nt; t += 2) {
            const bool last = (t == nt - 2);
            const char* a1 = cA + (size_t)(t + 1) * kstep;
            const char* a2 = last ? nA : cA + (size_t)(t + 2) * kstep; const char* b2 = last ? nB : cB + (size_t)(t + 2) * kstep;
            const char* a3 = a2 + kstep; const char* b3 = b2 + kstep;
            if (last && has_next) S.a_ready(nxt);
            if constexpr (SP2) {
            PG8_LDB(B0, 0, 0); PG8_LDB(B1, 0, 1); PG8_SCHED; PG8_LDA(At, 0, 0); PG8_STAGE(PG8_SA(1, 1), a1 + hstep, voffA);
            PG8_WAIT_V(8); PG8_WAIT_L(0); PG8_BAR; PG8_MMA(0, 0, At, B0); PG8_MMA(0, 1, At, B1); PG8_BAR; PG8_SCHED;
            PG8_LDA(At, 0, 1); PG8_STAGE(PG8_SB(0, 0), b2, voffB); PG8_STAGE(PG8_SB(0, 1), b2 + hstep, voffB); PG8_STAGE(PG8_SA(0, 0), a2, voffA);
            PG8_WAIT_V(8); PG8_WAIT_L(0); PG8_BAR; PG8_MMA(1, 0, At, B0); PG8_MMA(1, 1, At, B1); PG8_BAR; PG8_SCHED;
            PG8_LDB(B0, 1, 0); PG8_LDB(B1, 1, 1); PG8_SCHED; PG8_LDA(At, 1, 0); PG8_STAGE(PG8_SA(0, 1), a2 + hstep, voffA);
            PG8_WAIT_V(8); PG8_WAIT_L(0); PG8_BAR; PG8_MMA(0, 0, At, B0); PG8_MMA(0, 1, At, B1); PG8_BAR; PG8_SCHED;
            PG8_LDA(At, 1, 1); PG8_STAGE(PG8_SB(1, 0), b3, voffB); PG8_STAGE(PG8_SB(1, 1), b3 + hstep, voffB); PG8_STAGE(PG8_SA(1, 0), a3, voffA);
            PG8_WAIT_V(8); PG8_WAIT_L(0); PG8_BAR; PG8_MMA(1, 0, At, B0); PG8_MMA(1, 1, At, B1); PG8_BAR; PG8_SCHED;
            } else {
            PG8_LDB(B0, 0, 0); PG8_SCHED; PG8_LDA(At, 0, 0); PG8_STAGE(PG8_SA(1, 1), a1 + hstep, voffA);
            PG8_WAIT_L(8); PG8_BAR; PG8_WAIT_L(0); PG8_MMA(0, 0, At, B0); PG8_BAR; PG8_SCHED;
            PG8_LDB(B1, 0, 1); PG8_STAGE(PG8_SB(0, 0), b2, voffB);
            PG8_BAR; PG8_WAIT_L(0); PG8_MMA(0, 1, At, B1); PG8_BAR;
            PG8_LDA(At, 0, 1); PG8_STAGE(PG8_SA(0, 0), a2, voffA);
            PG8_BAR; PG8_WAIT_L(0); PG8_MMA(1, 0, At, B0); PG8_BAR; PG8_SCHED;
            PG8_STAGE(PG8_SB(0, 1), b2 + hstep, voffB);
            PG8_WAIT_V(6); PG8_BAR; PG8_MMA(1, 1, At, B1); PG8_BAR;
            PG8_LDB(B0, 1, 0); PG8_SCHED; PG8_LDA(At, 1, 0); PG8_STAGE(PG8_SA(0, 1), a2 + hstep, voffA);
            PG8_WAIT_L(8); PG8_BAR; PG8_WAIT_L(0); PG8_MMA(0, 0, At, B0); PG8_BAR; PG8_SCHED;
            PG8_LDB(B1, 1, 1); PG8_STAGE(PG8_SB(1, 0), b3, voffB);
            PG8_BAR; PG8_WAIT_L(0); PG8_MMA(0, 1, At, B1); PG8_BAR;
            PG8_LDA(At, 1, 1); PG8_STAGE(PG8_SA(1, 0), a3, voffA);
            PG8_BAR; PG8_WAIT_L(0); PG8_MMA(1, 0, At, B0); PG8_BAR; PG8_SCHED;
            PG8_STAGE(PG8_SB(1, 1), b3 + hstep, voffB);
            PG8_WAIT_V(6); PG8_BAR; PG8_MMA(1, 1, At, B1); PG8_BAR;
            }
        }
        if constexpr (ALIGN_EPI) { if (wr == 0) PG8_BAR; }
        if constexpr (!Epi::AFTER_DRAIN) { E(acc, cur, wr, wc, fr, fq); S.done(cur); }
        if (!has_next) break;
#pragma unroll
        for (int a = 0; a < 2; ++a)
#pragma unroll
            for (int b = 0; b < 2; ++b)
#pragma unroll
                for (int m = 0; m < 4; ++m)
#pragma unroll
                    for (int n = 0; n < 2; ++n) acc[a][b][m][n] = (f32x4){0.f, 0.f, 0.f, 0.f};
        cur = nxt; cA = nA; cB = nB; ++ui;
        if constexpr (ALIGN_EPI) { if (wr == 1) PG8_BAR; }
    }
    PG8_WAIT_V(0);
    if constexpr (!ALIGN_EPI) { if (wr == 0) PG8_BAR; }
    PG8_BAR;
    if constexpr (Epi::AFTER_DRAIN) { E.fused(acc, cur, wr, wc, fr, fq, lds, wid, lane); S.done(cur); }
#undef PG8_SA
#undef PG8_SB
#undef PG8_STAGE
#undef PG8_LDA
#undef PG8_LDB
#undef PG8_MMA
#undef PG8_WAIT_V
#undef PG8_WAIT_L
#undef PG8_BAR
#undef PG8_SCHED
}
}

#ifndef PG8_SP2
#define PG8_SP2 true
#endif
#ifndef PG8_ALIGN
#define PG8_ALIGN true
#endif
#include <hip/hip_bf16.h>
#include <cmath>
namespace attn_body {
using bf16=__hip_bfloat16;
using bf16x8=__attribute__((ext_vector_type(8)))short;
using s16x4=__attribute__((ext_vector_type(4)))short;
using f32x16=__attribute__((ext_vector_type(16)))float;
using u32x4=__attribute__((ext_vector_type(4)))unsigned;
constexpr int SEQ=2048,D=64;
constexpr int NW=8,QBLK=32,QB=QBLK*NW,KVBLK=64,NQB=SEQ/QB;
__device__ __forceinline__ int crow(int r,int hi){return (r&3)+8*(r>>2)+4*hi;}
#define SBAR() __builtin_amdgcn_sched_barrier(0)
constexpr int NSLOT=3, SLOTB=8192;
constexpr int LDS_K=0, LDS_V=NSLOT*SLOTB, LDS_WS=2*NSLOT*SLOTB, LDS_OST=LDS_WS+NW*64*4, LDS_STASH=LDS_OST+NW*4096, LDS_BYTES=LDS_STASH+NW*8192;
constexpr float LOG2E=1.4426950408889634f;
__device__ __forceinline__ void glds16(const void*gsrc,unsigned lds_dst){unsigned keep;
  asm volatile("s_mov_b32 %0, m0\n\ts_mov_b32 m0, %2\n\ts_nop 0\n\tglobal_load_lds_dwordx4 %1, off\n\ts_mov_b32 m0, %0":"=&s"(keep):"v"(gsrc),"s"(lds_dst):"memory");}
__device__ __forceinline__ float max3f(float a,float b,float c){float r;asm("v_max3_f32 %0, %1, %2, %3":"=v"(r):"v"(a),"v"(b),"v"(c));return r;}
__device__ __forceinline__ float max2f(float a,float b){float r;asm("v_max_f32_e32 %0, %1, %2":"=v"(r):"v"(a),"v"(b));return r;}
__device__ __forceinline__ float fadd_s(float a,float b){float r;asm("v_add_f32_e32 %0, %1, %2":"=v"(r):"v"(a),"v"(b));return r;}
__device__ __forceinline__ float fsub_s(float a,float b){float r;asm("v_sub_f32_e32 %0, %1, %2":"=v"(r):"v"(a),"v"(b));return r;}
typedef float f32x2_t __attribute__((ext_vector_type(2))); typedef __bf16 bf16x2_t __attribute__((ext_vector_type(2)));
__device__ __forceinline__ unsigned cvtpk_s(float lo,float hi){f32x2_t v={lo,hi};bf16x2_t b=__builtin_convertvector(v,bf16x2_t);return __builtin_bit_cast(unsigned,b);}
#define WAIT_BAR(N) asm volatile("s_waitcnt vmcnt(" #N ") lgkmcnt(0)\n\ts_barrier":::"memory")

__device__ __forceinline__ void qkt(f32x16&p0,f32x16&p1,const char*Kslot,const bf16x8*qr,const f32x16&negm,int r32,int hi){
  const char*kb=Kslot+hi*1024+r32*16;
  #pragma unroll
  for(int d0=0;d0<4;++d0){
    const bf16x8 b0=*reinterpret_cast<const bf16x8*>(kb+d0*2048);
    const bf16x8 b1=*reinterpret_cast<const bf16x8*>(kb+d0*2048+512);
    if(d0==0){p0=__builtin_amdgcn_mfma_f32_32x32x16_bf16(b0,qr[0],negm,0,0,0);p1=__builtin_amdgcn_mfma_f32_32x32x16_bf16(b1,qr[0],negm,0,0,0);}
    else{p0=__builtin_amdgcn_mfma_f32_32x32x16_bf16(b0,qr[d0],p0,0,0,0);p1=__builtin_amdgcn_mfma_f32_32x32x16_bf16(b1,qr[d0],p1,0,0,0);}}
}
typedef __attribute__((address_space(3))) const char* lds_cptr;
typedef short v4i16_t __attribute__((ext_vector_type(4)));
__device__ __forceinline__ void kload8(bf16x8*kf,lds_cptr kp){
  kf[0]=*(const __attribute__((address_space(3))) bf16x8*)(kp);      kf[1]=*(const __attribute__((address_space(3))) bf16x8*)(kp+512);
  kf[2]=*(const __attribute__((address_space(3))) bf16x8*)(kp+2048); kf[3]=*(const __attribute__((address_space(3))) bf16x8*)(kp+2560);
  kf[4]=*(const __attribute__((address_space(3))) bf16x8*)(kp+4096); kf[5]=*(const __attribute__((address_space(3))) bf16x8*)(kp+4608);
  kf[6]=*(const __attribute__((address_space(3))) bf16x8*)(kp+6144); kf[7]=*(const __attribute__((address_space(3))) bf16x8*)(kp+6656);
}
__device__ __forceinline__ void kload2(bf16x8*kf,lds_cptr kp,int j){ kf[2*j]=*(const __attribute__((address_space(3))) bf16x8*)(kp+j*2048); kf[2*j+1]=*(const __attribute__((address_space(3))) bf16x8*)(kp+j*2048+512); }
__device__ __forceinline__ s16x4 vtr(lds_cptr p){ return __builtin_bit_cast(s16x4,__builtin_amdgcn_ds_read_tr16_b64_v4i16((__attribute__((address_space(3))) v4i16_t*)p)); }
__device__ __forceinline__ float rowmax(const f32x16&p0,const f32x16&p1){
  float a=max3f(p0[0],p0[1],p1[0]),b=max3f(p0[2],p0[3],p1[1]);a=max3f(a,p1[2],p1[3]);
  #pragma unroll
  for(int r=4;r<16;r+=4){a=max3f(a,p0[r],p0[r+1]);b=max3f(b,p0[r+2],p0[r+3]);a=max3f(a,p1[r],p1[r+1]);b=max3f(b,p1[r+2],p1[r+3]);}
  const float m=max2f(a,b);
  auto rr=__builtin_amdgcn_permlane32_swap(__float_as_uint(m),__float_as_uint(m),false,false);
  return max2f(__uint_as_float(rr[0]),__uint_as_float(rr[1]));
}
__device__ __forceinline__ void pv(f32x16*o,int vb,bf16x8 pa0,bf16x8 pa1,bf16x8 pa2,bf16x8 pa3){
  #pragma unroll
  for(int d0=0;d0<2;++d0){s16x4 lo[4],hi[4];
    #pragma unroll
    for(int ks=0;ks<4;++ks){
      asm volatile("ds_read_b64_tr_b16 %0,%1 offset:%c2":"=&v"(lo[ks]):"v"(vb),"i"(d0*4096+ks*1024):"memory");
      asm volatile("ds_read_b64_tr_b16 %0,%1 offset:%c2":"=&v"(hi[ks]):"v"(vb),"i"(d0*4096+ks*1024+512):"memory");}
    asm volatile("s_waitcnt lgkmcnt(0)":::"memory");SBAR();
    #define PK(k) (bf16x8){lo[k][0],lo[k][1],lo[k][2],lo[k][3],hi[k][0],hi[k][1],hi[k][2],hi[k][3]}
    o[d0]=__builtin_amdgcn_mfma_f32_32x32x16_bf16(pa0,PK(0),o[d0],0,0,0);
    o[d0]=__builtin_amdgcn_mfma_f32_32x32x16_bf16(pa1,PK(1),o[d0],0,0,0);
    o[d0]=__builtin_amdgcn_mfma_f32_32x32x16_bf16(pa2,PK(2),o[d0],0,0,0);
    o[d0]=__builtin_amdgcn_mfma_f32_32x32x16_bf16(pa3,PK(3),o[d0],0,0,0);
    #undef PK
  }
}
struct AttnJob { const bf16* Q; int qp; const bf16* K; int kp; const bf16* V; int vp; bf16* O; int op; int npass; float lam; const float* gain; float oscale; };
typedef float f32x4a __attribute__((ext_vector_type(4)));
template<int THRL> __device__ __forceinline__ void attn_unit(const AttnJob& J,char*shm){
 for(int pass=0;pass<J.npass;++pass){
  int tid_=threadIdx.x; asm volatile("":"+v"(tid_)); const int tid=tid_,lane=tid&63,r32=lane&31,hi=lane>>5; const int wid=__builtin_amdgcn_readfirstlane(tid>>6);
  const bf16*Qw=J.Q+(long)(wid*QBLK)*J.qp+pass*64;
  const bf16*Kh=J.K,*Vh=J.V;
  const unsigned lds0=(unsigned)(uintptr_t)shm;
  float*wsf=(float*)(shm+LDS_WS)+wid*64;
  const bf16*ksrc=Kh+(long)lane*J.kp+wid*8;
  const bf16*vsrc=Vh+(long)(16*(wid&3)+(lane>>2))*J.vp+(wid>>2)*32+(lane&3)*8;
  const unsigned kdst=lds0+LDS_K+wid*1024, vdst=lds0+LDS_V+wid*1024;
  #define DMA_K(t,slot) glds16(ksrc+(long)(t)*KVBLK*J.kp,(unsigned)__builtin_amdgcn_readfirstlane(kdst+(slot)))
  #define DMA_V(t,slot) glds16(vsrc+(long)(t)*KVBLK*J.vp,(unsigned)__builtin_amdgcn_readfirstlane(vdst+(slot)))
  const int vb0=(int)(lds0+LDS_V)+((lane>>4)&1)*32+(lane&3)*8+(4*hi+((lane&15)>>2))*64;
  const char*Kbase=shm+LDS_K; bf16x8 kf[8];
  const lds_cptr shm3=(lds_cptr)shm; const lds_cptr kp0=shm3+LDS_K+hi*1024+r32*16; const lds_cptr vp0=shm3+LDS_V+((lane>>4)&1)*32+(lane&3)*8+(4*hi+((lane&15)>>2))*64;
  constexpr int NT=SEQ/KVBLK;
  DMA_K(0,0);DMA_V(0,0);DMA_K(1,SLOTB);
  bf16x8 qr[4];
  #pragma unroll
  for(int d0=0;d0<4;++d0)qr[d0]=*reinterpret_cast<const bf16x8*>(&Qw[(long)r32*J.qp+d0*16+hi*8]);
  float mhat=0.f,l_reg=0.f;f32x16 o[2];o[0]=f32x16{};o[1]=f32x16{};f32x16 negm=f32x16{};asm volatile("":"+v"(negm));
  #define CMASK(P0,P1,t) do{}while(0)
  bool resc=false;
  #define START(P0,P1) do{ const float rm=rowmax(P0,P1); resc=false; \
    { const float dl=rm; mhat=fadd_s(mhat,dl); \
      _Pragma("unroll") for(int r=0;r<16;++r){P0[r]=fsub_s(P0[r],dl);P1[r]=fsub_s(P1[r],dl);} \
      _Pragma("unroll") for(int r=0;r<16;++r)negm[r]=-mhat; asm volatile("":"+v"(negm)); } \
    _Pragma("unroll") for(int r=0;r<16;++r)P0[r]=__builtin_amdgcn_exp2f(P0[r]); }while(0)
  #define RESC() do{ if(resc){ asm volatile("s_waitcnt lgkmcnt(0)":::"memory"); \
      _Pragma("unroll") for(int d_=0;d_<2;++d_) _Pragma("unroll") for(int r=0;r<16;++r)o[d_][r]*=wsf[crow(r,hi)]; } }while(0)
  f32x16 pA0,pA1,pB0,pB1;
  int sl_prev=0,sl_cur=0,sl_next=SLOTB;
  #define ROT() do{sl_prev=sl_cur;sl_cur=sl_next;sl_next=(sl_next==(NSLOT-1)*SLOTB)?0:sl_next+SLOTB;}while(0)
  DMA_K(2,2*SLOTB);
  WAIT_BAR(3);
  qkt(pA0,pA1,Kbase,qr,negm,r32,hi);asm volatile("s_nop 15\n\ts_nop 7":"+v"(pA0),"+v"(pA1));CMASK(pA0,pA1,0);
  START(pA0,pA1);
  _Pragma("unroll") for(int r=0;r<16;++r)pA1[r]=__builtin_amdgcn_exp2f(pA1[r]);
  WAIT_BAR(0);
  DMA_K(3,0);DMA_V(1,SLOTB);
  ROT();
  kload8(kf,kp0+sl_cur);
  WAIT_BAR(2);
  s16x4 vlo[8],vhi[8]; u32x4 pw0,pw1,pw2,pw3;
  #define PKW(P,B) cvtpk_s(P[B],P[B+1])
  #define PAF(k) __builtin_bit_cast(bf16x8,pw##k)
  #define VFR(i) (bf16x8){vlo[i][0],vlo[i][1],vlo[i][2],vlo[i][3],vhi[i][0],vhi[i][1],vhi[i][2],vhi[i][3]}
  #define PIN(x) asm volatile("":"+v"(x))
  #define MX3(a,b,c) __builtin_fmaxf(__builtin_fmaxf((a),(b)),(c))
  #define GAPA(MF,A0,A1,A2,A3,W0,W1,PW) do{ MF; sacc+=A0; sacc+=A1; sacc+=A2; sacc+=A3; PIN(sacc); W0; W1; PIN(PW); SBAR(); }while(0)
  #define EX(v) __builtin_amdgcn_exp2f(v)
  #define GAPB(MF,X,B) do{ MF; X[B]=EX(X[B]); X[B+1]=EX(X[B+1]); X[B+2]=EX(X[B+2]); X[B+3]=EX(X[B+3]); PIN(X); SBAR(); }while(0)
  #define VRD(i) do{ vlo[i]=vtr(vp_+(((i)>>2)*4096+((i)&3)*1024)); vhi[i]=vtr(vp_+(((i)>>2)*4096+((i)&3)*1024+512)); }while(0)
  #define KRD(G,j) do{ if(G){ kload2(kf,kp0+sl_next,j); SBAR(); } }while(0)
  #define STEP(C0,C1,P0,P1,t,GK,GV,GL) do{ SBAR(); \
    const lds_cptr vp_=vp0+sl_prev; \
    VRD(0); SBAR(); float sacc=(P0[0]+P0[1]); \
    GAPA(C0=__builtin_amdgcn_mfma_f32_32x32x16_bf16(kf[0],qr[0],negm,0,0,0), P0[2],P0[3],P0[4],P0[5],     pw0[0]=PKW(P0,0), pw0[1]=PKW(P0,2), pw0); \
    VRD(4); SBAR(); GAPA(C1=__builtin_amdgcn_mfma_f32_32x32x16_bf16(kf[1],qr[0],negm,0,0,0), P0[6],P0[7],P0[8],P0[9],     pw0[2]=PKW(P0,4), pw0[3]=PKW(P0,6), pw0); \
    VRD(1); SBAR(); GAPA(C0=__builtin_amdgcn_mfma_f32_32x32x16_bf16(kf[2],qr[1],C0,0,0,0),   P0[10],P0[11],P0[12],P0[13], pw1[0]=PKW(P0,8), pw1[1]=PKW(P0,10), pw1); \
    VRD(5); SBAR(); GAPA(C1=__builtin_amdgcn_mfma_f32_32x32x16_bf16(kf[3],qr[1],C1,0,0,0),   P0[14],P0[15],P1[0],P1[1],   pw1[2]=PKW(P0,12),pw1[3]=PKW(P0,14), pw1); \
    VRD(2); SBAR(); GAPA(C0=__builtin_amdgcn_mfma_f32_32x32x16_bf16(kf[4],qr[2],C0,0,0,0),   P1[2],P1[3],P1[4],P1[5],     pw2[0]=PKW(P1,0), pw2[1]=PKW(P1,2), pw2); \
    VRD(6); SBAR(); GAPA(C1=__builtin_amdgcn_mfma_f32_32x32x16_bf16(kf[5],qr[2],C1,0,0,0),   P1[6],P1[7],P1[8],P1[9],     pw2[2]=PKW(P1,4), pw2[3]=PKW(P1,6), pw2); \
    VRD(3); SBAR(); GAPA(C0=__builtin_amdgcn_mfma_f32_32x32x16_bf16(kf[6],qr[3],C0,0,0,0),   P1[10],P1[11],P1[12],P1[13], pw3[0]=PKW(P1,8), pw3[1]=PKW(P1,10), pw3); \
    VRD(7); SBAR(); GAPA(C1=__builtin_amdgcn_mfma_f32_32x32x16_bf16(kf[7],qr[3],C1,0,0,0),   P1[14],P1[15],0.f,0.f,       pw3[2]=PKW(P1,12),pw3[3]=PKW(P1,14), pw3); \
    l_reg+=sacc; \
    if(GK){DMA_K((t)+3,sl_cur);} if(GV){DMA_V((t)+1,sl_next);} \
    CMASK(C0,C1,t); \
    { float a=MX3(C0[0],C0[1],C1[0]),b=MX3(C0[2],C0[3],C1[1]); a=MX3(a,C1[2],C1[3]); \
      _Pragma("unroll") for(int r=4;r<16;r+=4){a=MX3(a,C0[r],C0[r+1]);b=MX3(b,C0[r+2],C0[r+3]);a=MX3(a,C1[r],C1[r+1]);b=MX3(b,C1[r+2],C1[r+3]);} \
      float rm=__builtin_fmaxf(a,b); { auto rr=__builtin_amdgcn_permlane32_swap(__float_as_uint(rm),__float_as_uint(rm),false,false); rm=__builtin_fmaxf(__uint_as_float(rr[0]),__uint_as_float(rr[1])); } \
      resc=false; \
      if(__builtin_expect(__any(rm>(float)THRL),0)){ const float dl=__builtin_fmaxf(rm,0.f); mhat+=dl; \
        _Pragma("unroll") for(int r=0;r<16;++r){C0[r]-=dl;C1[r]-=dl;} \
        _Pragma("unroll") for(int r=0;r<16;++r)negm[r]=-mhat; asm volatile("":"+v"(negm)); \
        const float f=__builtin_amdgcn_exp2f(-dl); l_reg*=f; if(hi==0)wsf[r32]=f; resc=true; } } \
    SBAR(); \
    GAPB(o[0]=__builtin_amdgcn_mfma_f32_32x32x16_bf16(PAF(0),VFR(0),o[0],0,0,0), C0,0); \
    GAPB(o[1]=__builtin_amdgcn_mfma_f32_32x32x16_bf16(PAF(0),VFR(4),o[1],0,0,0), C0,4); \
    KRD(GL,0); GAPB(o[0]=__builtin_amdgcn_mfma_f32_32x32x16_bf16(PAF(1),VFR(1),o[0],0,0,0), C0,8); \
    KRD(GL,1); GAPB(o[1]=__builtin_amdgcn_mfma_f32_32x32x16_bf16(PAF(1),VFR(5),o[1],0,0,0), C0,12); \
    KRD(GL,2); GAPB(o[0]=__builtin_amdgcn_mfma_f32_32x32x16_bf16(PAF(2),VFR(2),o[0],0,0,0), C1,0); \
    KRD(GL,3); GAPB(o[1]=__builtin_amdgcn_mfma_f32_32x32x16_bf16(PAF(2),VFR(6),o[1],0,0,0), C1,4); \
    GAPB(o[0]=__builtin_amdgcn_mfma_f32_32x32x16_bf16(PAF(3),VFR(3),o[0],0,0,0), C1,8); \
    GAPB(o[1]=__builtin_amdgcn_mfma_f32_32x32x16_bf16(PAF(3),VFR(7),o[1],0,0,0), C1,12); \
    }while(0)
  int t=1;
  #undef CMASK
  #define CMASK(P0,P1,t) do{}while(0)
  for(;t+5<NT;t+=2){
    STEP(pB0,pB1,pA0,pA1,t,true,true,true);     WAIT_BAR(2); RESC(); ROT();
    STEP(pA0,pA1,pB0,pB1,t+1,true,true,true);   WAIT_BAR(2); RESC(); ROT();
  }
  #undef CMASK
  #define CMASK(P0,P1,t) do{}while(0)
  #define ENDW(tt) do{ if((tt)+3<NT){WAIT_BAR(2);} else if((tt)+2<NT){WAIT_BAR(1);} else {WAIT_BAR(0);} }while(0)
  for(;t+1<NT;t+=2){
    STEP(pB0,pB1,pA0,pA1,t,(t+3<NT),(t+1<NT),(t+1<NT));       ENDW(t);   RESC(); ROT();
    STEP(pA0,pA1,pB0,pB1,t+1,(t+4<NT),(t+2<NT),(t+2<NT));     ENDW(t+1); RESC(); ROT();
  }
  STEP(pB0,pB1,pA0,pA1,NT-1,false,false,false); RESC();
  { float sacc=pB0[0]+pB0[1]; _Pragma("unroll") for(int r=2;r<16;++r)sacc+=pB0[r]; _Pragma("unroll") for(int r=0;r<16;++r)sacc+=pB1[r]; l_reg+=sacc;
    pw0=(u32x4){PKW(pB0,0),PKW(pB0,2),PKW(pB0,4),PKW(pB0,6)};pw1=(u32x4){PKW(pB0,8),PKW(pB0,10),PKW(pB0,12),PKW(pB0,14)};pw2=(u32x4){PKW(pB1,0),PKW(pB1,2),PKW(pB1,4),PKW(pB1,6)};pw3=(u32x4){PKW(pB1,8),PKW(pB1,10),PKW(pB1,12),PKW(pB1,14)};
    SBAR(); pv(o,vb0+sl_cur,PAF(0),PAF(1),PAF(2),PAF(3)); }
  #undef PKW
  #undef PAF
  #undef VFR
  #undef PIN
  #undef MX3
  #undef GAPA
  #undef GAPB
  #undef EX
  #undef VRD
  #undef KRD
  #undef STEP
  #undef ENDW
  {auto rr=__builtin_amdgcn_permlane32_swap(__float_as_uint(l_reg),__float_as_uint(l_reg),false,false);l_reg=__uint_as_float(rr[0])+__uint_as_float(rr[1]);}
  if(hi==0)wsf[32+r32]=l_reg;asm volatile("s_waitcnt lgkmcnt(0)":::"memory");
  float rli[16];
  #pragma unroll
  for(int r=0;r<16;++r)rli[r]=__builtin_amdgcn_rcpf(wsf[32+crow(r,hi)]);
  bf16*Ow=J.O+(long)(wid*QBLK)*J.op;
  if(J.npass==1){ bf16*stg=(bf16*)(shm+LDS_OST)+wid*2048;
    #pragma unroll
    for(int r=0;r<16;++r){const int orow=crow(r,hi);
      #pragma unroll
      for(int d0=0;d0<2;++d0)stg[orow*64+d0*32+r32]=__float2bfloat16(o[d0][r]*rli[r]);}
    asm volatile("s_waitcnt lgkmcnt(0)":::"memory");
    #pragma unroll
    for(int i=0;i<4;++i){const int row=i*8+(lane>>3),ch=lane&7; const u32x4 v=*(const u32x4*)(stg+row*64+ch*8); *(u32x4*)(Ow+(long)row*J.op+ch*8)=v;} }
  else { float*st=(float*)(shm+LDS_STASH)+wid*2048;
    if(pass==0){
      #pragma unroll
      for(int r=0;r<16;++r){
        #pragma unroll
        for(int d0=0;d0<2;++d0)st[(r*2+d0)*64+lane]=o[d0][r]*rli[r];}
    } else {
      float dv[2][16];
      #pragma unroll
      for(int r=0;r<16;++r){
        #pragma unroll
        for(int d0=0;d0<2;++d0)dv[d0][r]=st[(r*2+d0)*64+lane]-J.lam*(o[d0][r]*rli[r]);}
      asm volatile("s_waitcnt lgkmcnt(0)":::"memory");
      #pragma unroll
      for(int r=0;r<16;++r){const int orow=crow(r,hi);
        #pragma unroll
        for(int d0=0;d0<2;++d0)st[orow*64+d0*32+r32]=dv[d0][r];}
      asm volatile("s_waitcnt lgkmcnt(0)":::"memory");
      #pragma unroll
      for(int i=0;i<4;++i){const int row=i*8+(lane>>3),ch=lane&7;
        const f32x4a a=*(const f32x4a*)(st+row*64+ch*8), b2=*(const f32x4a*)(st+row*64+ch*8+4);
        float ss=(a[0]*a[0]+a[1]*a[1])+(a[2]*a[2]+a[3]*a[3])+(b2[0]*b2[0]+b2[1]*b2[1])+(b2[2]*b2[2]+b2[3]*b2[3]);
        ss+=__shfl_xor(ss,1);ss+=__shfl_xor(ss,2);ss+=__shfl_xor(ss,4);
        const float rs=rsqrtf(ss*(1.0f/64.0f)+1e-6f)*J.oscale;
        const f32x4a g0=*(const f32x4a*)(J.gain+ch*8), g1=*(const f32x4a*)(J.gain+ch*8+4);
        u32x4 v; v[0]=cvtpk_s(a[0]*rs*g0[0],a[1]*rs*g0[1]); v[1]=cvtpk_s(a[2]*rs*g0[2],a[3]*rs*g0[3]); v[2]=cvtpk_s(b2[0]*rs*g1[0],b2[1]*rs*g1[1]); v[3]=cvtpk_s(b2[2]*rs*g1[2],b2[3]*rs*g1[3]);
        *(u32x4*)(Ow+(long)row*J.op+ch*8)=v;}
    } }
  asm volatile("s_waitcnt lgkmcnt(0)\n\ts_barrier":::"memory");
  #undef DMA_K
  #undef DMA_V
  #undef CMASK
  #undef START
  #undef RESC
  #undef ROT
 }
}
constexpr int ATTN_LDS_BYTES=LDS_BYTES;
#undef SBAR
#undef WAIT_BAR
}
#define LAS __attribute__((address_space(3)))
typedef unsigned short bfu;
typedef unsigned v4u __attribute__((ext_vector_type(4)));
typedef unsigned v2u __attribute__((ext_vector_type(2)));
typedef float f32x4 __attribute__((ext_vector_type(4)));
typedef short bf16x8 __attribute__((ext_vector_type(8)));
constexpr int NWAVES = 8, NTHR = 512;
constexpr int BATCH = 32, SEQ = 2048, DM = 1024, M = BATCH * SEQ, NIN = 3072, DFF = 4096, NMOD = 6144;
constexpr size_t MiB = 1u << 20;
constexpr size_t WS_CTL = 0, CTL_ZERO_BYTES = 4096;
constexpr size_t WS_MOD = 1 * MiB;
constexpr size_t WS_ROPE = 3 * MiB;
constexpr size_t WS_WIN = 4 * MiB, WS_WOUT = 16 * MiB, WS_WFF1 = 20 * MiB, WS_WFF2 = 36 * MiB;
constexpr size_t WS_HN = 64 * MiB;
constexpr size_t WS_MIX = 192 * MiB;
constexpr size_t WS_OF = 320 * MiB;
constexpr size_t WS_Z = 384 * MiB;
constexpr size_t WS_QA = 768 * MiB, WS_KA = 816 * MiB, WS_QB = 832 * MiB, WS_KB = 928 * MiB;
constexpr size_t WS_HID = 384 * MiB;
constexpr size_t WS_END = 976 * MiB;
constexpr int LDS_TOTAL = 149504;
static_assert(attn_body::ATTN_LDS_BYTES <= LDS_TOTAL && pg8::STAGE_BYTES <= LDS_TOTAL, "lds");

struct Params {
    const float *x, *c, *w_mod, *b_mod, *w_in, *a_qk_norm, *diff_lambda, *diff_subln, *hgrn_lb, *hgrn_norm, *w_out, *w_ff1, *w_ff2, *final_norm;
    float* out; unsigned char* ws;
};

__device__ __forceinline__ float bf2f(unsigned short u) { return __uint_as_float((unsigned)u << 16); }
__device__ __forceinline__ unsigned pkbf(float lo, float hi) { typedef float f2 __attribute__((ext_vector_type(2))); typedef __bf16 b2 __attribute__((ext_vector_type(2))); f2 v = {lo, hi}; b2 b = __builtin_convertvector(v, b2); return __builtin_bit_cast(unsigned, b); }
__device__ __forceinline__ unsigned short f2bf1(float x) { return (unsigned short)(pkbf(x, 0.f) & 0xffffu); }
__device__ __forceinline__ float wave_sum(float v) {
#pragma unroll
    for (int o = 1; o < 64; o <<= 1) v += __shfl_xor(v, o);
    return v;
}
__device__ __forceinline__ float sigmoidf_(float x) { return 1.0f / (1.0f + __expf(-x)); }

__device__ __forceinline__ void p0_transpose_item(const float* W, int K, int N, bfu* WT, LAS float* scr, int item, int lane) {
    const int nblk = N / 32, kb = item / nblk, nb = item % nblk, k0 = 64 * kb, n0 = 32 * nb;
#pragma unroll 8
    for (int i = 0; i < 32; ++i) { const int kk = 2 * i + (lane >> 5); scr[kk * 33 + (lane & 31)] = W[(size_t)(k0 + kk) * N + n0 + (lane & 31)]; }
    asm volatile("s_waitcnt lgkmcnt(0)" ::: "memory");
    const int c = lane & 7;
#pragma unroll
    for (int j = 0; j < 4; ++j) { const int n = (lane >> 3) + 8 * j; const LAS float* s = scr + (8 * c) * 33 + n;
        v4u o; o.x = pkbf(s[0 * 33], s[1 * 33]); o.y = pkbf(s[2 * 33], s[3 * 33]); o.z = pkbf(s[4 * 33], s[5 * 33]); o.w = pkbf(s[6 * 33], s[7 * 33]);
        *(v4u*)(WT + (size_t)(n0 + n) * K + k0 + 8 * c) = o; }
    asm volatile("s_waitcnt lgkmcnt(0)" ::: "memory");
}

__device__ __forceinline__ void phase_prologue(const Params& p, LAS unsigned char* lds, int tid, int lane, int wave) {
    const int G = gridDim.x;
    float* MOD = (float*)(p.ws + WS_MOD);
    LAS float* SC = (LAS float*)lds;
    for (int u = blockIdx.x; u < 2 * (NMOD / 64); u += G) {
        const int l = u / (NMOD / 64), cg0 = (u % (NMOD / 64)) * 64;
        for (int i = tid; i < BATCH * DM; i += NTHR) { const float cv = p.c[i]; SC[i] = cv * sigmoidf_(cv); }
        __syncthreads();
        float acc[32];
#pragma unroll
        for (int b = 0; b < 32; ++b) acc[b] = 0.f;
        const float* wp = p.w_mod + ((size_t)l * DM + wave * 128) * NMOD + cg0 + lane;
        for (int k4 = 0; k4 < 128; k4 += 4) {
            const float w0 = wp[(size_t)(k4 + 0) * NMOD], w1 = wp[(size_t)(k4 + 1) * NMOD], w2 = wp[(size_t)(k4 + 2) * NMOD], w3 = wp[(size_t)(k4 + 3) * NMOD];
#pragma unroll
            for (int b = 0; b < 32; ++b) { const f32x4 s = *(const LAS f32x4*)(SC + b * DM + wave * 128 + k4); acc[b] += s[0] * w0 + s[1] * w1 + s[2] * w2 + s[3] * w3; }
        }
        __syncthreads();
        LAS float* RED = (LAS float*)lds;
#pragma unroll
        for (int b = 0; b < 32; ++b) RED[(wave * 32 + b) * 64 + lane] = acc[b];
        __syncthreads();
#pragma unroll
        for (int bb = 0; bb < 4; ++bb) { const int b = wave * 4 + bb; float s = 0.f;
#pragma unroll
            for (int w = 0; w < 8; ++w) s += RED[(w * 32 + b) * 64 + lane];
            MOD[((size_t)l * BATCH + b) * NMOD + cg0 + lane] = s + p.b_mod[l * NMOD + cg0 + lane]; }
        __syncthreads();
    }
    {
        float* ROPE = (float*)(p.ws + WS_ROPE);
        for (int i = blockIdx.x * NTHR + tid; i < 2048 * 16; i += G * NTHR) {
            const int pos = i >> 4, j = i & 15;
            const double inv = exp2(-(double)j * (13.287712379549449 / 16.0));
            const double rev = (double)pos * inv * 0.15915494309189535;
            const float fr = (float)(rev - floor(rev));
            ROPE[2 * i] = __builtin_amdgcn_cosf(fr); ROPE[2 * i + 1] = __builtin_amdgcn_sinf(fr);
        }
    }
    {
        LAS float* scr = (LAS float*)(lds + wave * 16384);
        const int gw = blockIdx.x * NWAVES + wave, NGW = G * NWAVES;
        constexpr int I_IN = (DM / 64) * (NIN / 32), I_OUT = (DM / 64) * (DM / 32), I_F1 = (DM / 64) * (DFF / 32), I_F2 = (DFF / 64) * (DM / 32);
        constexpr int PER_L = I_IN + I_OUT + I_F1 + I_F2;
        for (int it = gw; it < 2 * PER_L; it += NGW) {
            const int l = it / PER_L; int r = it % PER_L;
            if (r < I_IN) { p0_transpose_item(p.w_in + (size_t)l * DM * NIN, DM, NIN, (bfu*)(p.ws + WS_WIN) + (size_t)l * NIN * DM, scr, r, lane); continue; } r -= I_IN;
            if (r < I_OUT) { p0_transpose_item(p.w_out + (size_t)l * DM * DM, DM, DM, (bfu*)(p.ws + WS_WOUT) + (size_t)l * DM * DM, scr, r, lane); continue; } r -= I_OUT;
            if (r < I_F1) { p0_transpose_item(p.w_ff1 + (size_t)l * DM * DFF, DM, DFF, (bfu*)(p.ws + WS_WFF1) + (size_t)l * DFF * DM, scr, r, lane); continue; } r -= I_F1;
            p0_transpose_item(p.w_ff2 + (size_t)l * DFF * DM, DFF, DM, (bfu*)(p.ws + WS_WFF2) + (size_t)l * DM * DFF, scr, r, lane);
        }
    }
}

__device__ __forceinline__ void phase_modnorm(const float* xin, const float* modl  , int off_sh, int off_sc, bfu* HN, int lane, int wave) {
    const int gw = blockIdx.x * NWAVES + wave, NGW = gridDim.x * NWAVES;
    for (int m = gw; m < M; m += NGW) {
        const f32x4* xr = (const f32x4*)(xin + (size_t)m * DM) + lane;
        const float* mb = modl + (size_t)(m >> 11) * NMOD;
        f32x4 v[4]; float s = 0.f;
#pragma unroll
        for (int j = 0; j < 4; ++j) { v[j] = xr[64 * j]; s += (v[j][0] * v[j][0] + v[j][1] * v[j][1]) + (v[j][2] * v[j][2] + v[j][3] * v[j][3]); }
        const float rs = rsqrtf(wave_sum(s) * (1.f / DM) + 1e-6f);
        unsigned long long* o8 = (unsigned long long*)(HN + (size_t)m * DM) + lane;
#pragma unroll
        for (int j = 0; j < 4; ++j) { const f32x4 sc = *((const f32x4*)(mb + off_sc) + lane + 64 * j), sh = *((const f32x4*)(mb + off_sh) + lane + 64 * j);
            const f32x4 y = v[j] * rs * (sc + 1.0f) + sh;
            o8[64 * j] = (unsigned long long)pkbf(y[0], y[1]) | ((unsigned long long)pkbf(y[2], y[3]) << 32); }
    }
}
__device__ __forceinline__ void phase_finalnorm(float* x, const float* gain, int lane, int wave) {
    const int gw = blockIdx.x * NWAVES + wave, NGW = gridDim.x * NWAVES;
    for (int m = gw; m < M; m += NGW) {
        f32x4* xr = (f32x4*)(x + (size_t)m * DM) + lane;
        f32x4 v[4]; float s = 0.f;
#pragma unroll
        for (int j = 0; j < 4; ++j) { v[j] = xr[64 * j]; s += (v[j][0] * v[j][0] + v[j][1] * v[j][1]) + (v[j][2] * v[j][2] + v[j][3] * v[j][3]); }
        const float rs = rsqrtf(wave_sum(s) * (1.f / DM) + 1e-6f);
#pragma unroll
        for (int j = 0; j < 4; ++j) { const f32x4 g = *((const f32x4*)gain + lane + 64 * j); xr[64 * j] = v[j] * rs * g; }
    }
}

__device__ __forceinline__ void unpack8(const v4u r, float (&v)[8]) {
#pragma unroll
    for (int i = 0; i < 4; ++i) { v[2 * i] = __uint_as_float(r[i] << 16); v[2 * i + 1] = __uint_as_float(r[i] & 0xffff0000u); }
}
__device__ __forceinline__ v4u pack8(const float (&v)[8]) { v4u o; o[0] = pkbf(v[0], v[1]); o[1] = pkbf(v[2], v[3]); o[2] = pkbf(v[4], v[5]); o[3] = pkbf(v[6], v[7]); return o; }
__device__ __forceinline__ void rope8(float (&v)[8], const float* tab, bool second) {
    float pv[8];
#pragma unroll
    for (int k = 0; k < 8; ++k) pv[k] = __shfl_xor(v[k], 2);
#pragma unroll
    for (int k4 = 0; k4 < 4; ++k4) { const f32x4 cs = *(const f32x4*)(tab + 4 * k4);
        const int k = 2 * k4;
        v[k] = second ? v[k] * cs[0] + pv[k] * cs[1] : v[k] * cs[0] - pv[k] * cs[1];
        v[k + 1] = second ? v[k + 1] * cs[2] + pv[k + 1] * cs[3] : v[k + 1] * cs[2] - pv[k + 1] * cs[3]; }
}
__device__ __forceinline__ void phase_post(const Params& p, int l, int lane, int wave) {
    const bfu* Z = (const bfu*)(p.ws + WS_Z); const float* ROPE = (const float*)(p.ws + WS_ROPE);
    bfu* QA = (bfu*)(p.ws + WS_QA); bfu* KA = (bfu*)(p.ws + WS_KA); bfu* QB = (bfu*)(p.ws + WS_QB); bfu* KB = (bfu*)(p.ws + WS_KB);
    const float C2A = 0.125f * attn_body::LOG2E, C2B = 0.17677669529663687f * attn_body::LOG2E;
    const int gw = blockIdx.x * NWAVES + wave, NGW = gridDim.x * NWAVES;
    for (int m = gw; m < M; m += NGW) {
        const int s = m & 2047, prow = s >> 6, pcol = s & 63;
        const bfu* zr = Z + (size_t)m * NIN;
        {
            const int head = lane >> 3, ch = lane & 7;
            float v[8]; unpack8(*(const v4u*)(zr + head * 64 + ch * 8), v);
            float ss = 0.f;
#pragma unroll
            for (int k = 0; k < 8; ++k) ss += v[k] * v[k];
            ss += __shfl_xor(ss, 1); ss += __shfl_xor(ss, 2); ss += __shfl_xor(ss, 4);
            const float rs = rsqrtf(ss * (1.f / 64.f) + 1e-6f);
            const float* gp = p.a_qk_norm + l * 128 + (head < 6 ? 0 : 64) + ch * 8;
            const f32x4 g0 = *(const f32x4*)gp, g1 = *(const f32x4*)(gp + 4);
#pragma unroll
            for (int k = 0; k < 4; ++k) { v[k] *= rs * g0[k]; v[k + 4] *= rs * g1[k]; }
            const int pos = (ch & 4) ? pcol : prow;
            rope8(v, ROPE + (pos * 16 + 8 * (ch & 1)) * 2, (ch & 2) != 0);
            if (head < 6) {
#pragma unroll
                for (int k = 0; k < 8; ++k) v[k] *= C2A;
                *(v4u*)(QA + (size_t)m * 384 + head * 64 + ch * 8) = pack8(v);
            } else *(v4u*)(KA + (size_t)m * 128 + (head - 6) * 64 + ch * 8) = pack8(v);
        }
        {
            const bool act = lane < 48; const int ln = act ? lane : lane - 48;
            const int hc = ln >> 2, ch = ln & 3;
            const float* tab = ROPE + (s * 16 + 8 * (ch & 1)) * 2;
            float v[8]; unpack8(*(const v4u*)(zr + 640 + hc * 32 + ch * 8), v);
            rope8(v, tab, (ch & 2) != 0);
#pragma unroll
            for (int k = 0; k < 8; ++k) v[k] *= C2B;
            if (act) { const int comp = hc & 1; bfu* qd = QB + (size_t)m * 768 + hc * 64;
                *(v4u*)(qd + comp * 32 + ch * 8) = pack8(v); *(v4u*)(qd + (1 - comp) * 32 + ch * 8) = (v4u){0u, 0u, 0u, 0u}; }
            unpack8(*(const v4u*)(zr + 1024 + hc * 32 + ch * 8), v);
            rope8(v, tab, (ch & 2) != 0);
            if (act) *(v4u*)(KB + (size_t)m * 384 + hc * 32 + ch * 8) = pack8(v);
        }
    }
}
namespace hg {
constexpr int PB = 144;
constexpr int QE = 0, QC = 9216, KV = 18432, KLT = 55296, VT = 64512, ST = 73728, PP = 82944, TOT = 92160, AA = 94208, OO = 94464, LDS_BYTES = OO + 64 * 68 * 4;
static_assert(LDS_BYTES <= LDS_TOTAL, "hgrn lds");
#define HG_MFMA(a, b, c) __builtin_amdgcn_mfma_f32_16x16x32_bf16(a, b, c, 0, 0, 0)
#define HG_LD8(off) (*(const LAS bf16x8*)(L + (off)))
__device__ __forceinline__ void hgrn_scan(LAS unsigned char* L, const Params& p, int layer, int b, int h, int dir) {
    int tid_ = threadIdx.x; asm volatile("" : "+v"(tid_));
    const int tid = tid_, lane = tid & 63, g = __builtin_amdgcn_readfirstlane(tid >> 6), fr = lane & 15, fq = lane >> 4;
    const bfu* Z = (const bfu*)(p.ws + WS_Z); float* OF = (float*)(p.ws + (dir ? WS_HN : WS_OF));
    const int d = lane;
    float lb = 0.f;
    if (layer == 1) { const float b0 = p.hgrn_lb[h * 64 + d], b1 = p.hgrn_lb[256 + h * 64 + d]; lb = fminf(fmaxf(1.0f / (1.0f + __expf(b0 - b1)), 0.f), 1.f); }
    const float oml = 1.0f - lb;
    const int I = g >> 1, jh = g & 1;
    for (int i = tid; i < 64 * PB / 4; i += NTHR) ((LAS unsigned*)(L + ST))[i] = 0u;
    f32x4 Sreg[2]; Sreg[0] = (f32x4){0.f, 0.f, 0.f, 0.f}; Sreg[1] = Sreg[0];
    const int qcol = 1792 + h * 64 + d, fcol = (dir ? 2304 : 2048) + h * 64 + d, vcol = 2560 + h * 64 + d;
    const long rstep = dir ? -(long)NIN : (long)NIN;
    const bfu* zrow = Z + ((size_t)b * SEQ + (dir ? 2047 - 8 * g : 8 * g)) * NIN;
    unsigned short rq[8], rf[8], rv[8];
#pragma unroll
    for (int j = 0; j < 8; ++j) { const bfu* zr = zrow + rstep * j; rq[j] = zr[qcol]; rf[j] = zr[fcol]; rv[j] = zr[vcol]; }
    for (int c = 0; c < 32; ++c) {
        float bl[8], qv[8], kk[8]; unsigned short vb[8]; float run = 0.f;
#pragma unroll
        for (int j = 0; j < 8; ++j) {
            const float zq = bf2f(rq[j]); float zf = bf2f(rf[j]); vb[j] = rv[j];
            zf = fminf(fmaxf(zf, -30.f), 30.f);
            const float e = __expf(-zf), sig = __builtin_amdgcn_rcpf(1.0f + e);
            const float f = lb + oml * sig;
            run += __logf(fmaxf(f, 1e-6f)); bl[j] = run; kk[j] = oml * e * sig;
            qv[j] = zq * __builtin_amdgcn_rcpf(1.0f + __expf(-zq)) * 0.125f;
        }
        ((LAS float*)(L + TOT))[g * 64 + d] = run;
        if (c < 31) {
            const bfu* zn = zrow + rstep * 64 * (c + 1);
#pragma unroll
            for (int j = 0; j < 8; ++j) { const bfu* zr = zn + rstep * j; rq[j] = zr[qcol]; rf[j] = zr[fcol]; rv[j] = zr[vcol]; }
        }
        __syncthreads();
        float R1 = 0.f, R2 = 0.f, R3 = 0.f, blast, sub = 0.f;
        { float pp = 0.f;
#pragma unroll
          for (int g2 = 0; g2 < 8; ++g2) { const float tv = ((const LAS float*)(L + TOT))[g2 * 64 + d]; if (g2 == 2) R1 = pp; if (g2 == 4) R2 = pp; if (g2 == 6) R3 = pp; if (g2 + 1 == g && jh == 1) sub = tv; pp += tv; }
          blast = pp; }
        const float RI = I == 0 ? 0.f : (I == 1 ? R1 : (I == 2 ? R2 : R3));
        const float EI = __expf(RI), F1 = __expf(R1 - RI), F2 = __expf(R2 - RI), F3 = __expf(R3 - RI), GL = __expf(blast - RI);
#pragma unroll
        for (int j = 0; j < 8; ++j) {
            const int t = 8 * g + j; const float lc = sub + bl[j];
            const float qe = qv[j] * __expf(lc), kb = kk[j] * __expf(fminf(-lc, 80.f));
            *(LAS unsigned short*)(L + QE + t * PB + d * 2) = f2bf1(qe);
            *(LAS unsigned short*)(L + QC + t * PB + d * 2) = f2bf1(qe * EI);
            if (I == 0) *(LAS unsigned short*)(L + KV + 0 * 9216 + t * PB + d * 2) = f2bf1(kb);
            if (I <= 1) *(LAS unsigned short*)(L + KV + 1 * 9216 + t * PB + d * 2) = f2bf1(I == 1 ? kb : kb * F1);
            if (I <= 2) *(LAS unsigned short*)(L + KV + 2 * 9216 + t * PB + d * 2) = f2bf1(I == 2 ? kb : kb * F2);
            *(LAS unsigned short*)(L + KV + 3 * 9216 + t * PB + d * 2) = f2bf1(I == 3 ? kb : kb * F3);
            bl[j] = kb * GL;
        }
        { unsigned klp[4], vp[4];
#pragma unroll
          for (int j = 0; j < 4; ++j) { klp[j] = pkbf(bl[2 * j], bl[2 * j + 1]); vp[j] = (unsigned)vb[2 * j] | ((unsigned)vb[2 * j + 1] << 16); }
          *(LAS v4u*)(L + KLT + d * PB + g * 16) = (v4u){klp[0], klp[1], klp[2], klp[3]};
          *(LAS v4u*)(L + VT + d * PB + g * 16) = (v4u){vp[0], vp[1], vp[2], vp[3]}; }
        if (g == 0) ((LAS float*)(L + AA))[d] = __expf(blast);
        __syncthreads();
#pragma unroll
        for (int jj = 0; jj < 2; ++jj) { const int Jb = 2 * jh + jj;
            f32x4 acc = (f32x4){0.f, 0.f, 0.f, 0.f};
            if (Jb <= I) {
#pragma unroll
                for (int k2 = 0; k2 < 2; ++k2) acc = HG_MFMA(HG_LD8(QE + (16 * I + fr) * PB + (k2 * 32 + 8 * fq) * 2), HG_LD8(KV + I * 9216 + (16 * Jb + fr) * PB + (k2 * 32 + 8 * fq) * 2), acc);
            }
#pragma unroll
            for (int i = 0; i < 4; ++i) { const float val = (Jb < I || (Jb == I && fr <= 4 * fq + i)) ? acc[i] : 0.f;
                *(LAS unsigned short*)(L + PP + (16 * I + 4 * fq + i) * PB + (16 * Jb + fr) * 2) = f2bf1(val); }
        }
        __syncthreads();
        const f32x4 a4 = *(const LAS f32x4*)(L + AA + (16 * I + 4 * fq) * 4);
#pragma unroll
        for (int nn = 0; nn < 2; ++nn) { const int n = 2 * jh + nn;
            f32x4 acc = (f32x4){0.f, 0.f, 0.f, 0.f};
#pragma unroll
            for (int k2 = 0; k2 < 2; ++k2) acc = HG_MFMA(HG_LD8(PP + (16 * I + fr) * PB + (k2 * 32 + 8 * fq) * 2), HG_LD8(VT + (16 * n + fr) * PB + (k2 * 32 + 8 * fq) * 2), acc);
#pragma unroll
            for (int k2 = 0; k2 < 2; ++k2) acc = HG_MFMA(HG_LD8(QC + (16 * I + fr) * PB + (k2 * 32 + 8 * fq) * 2), HG_LD8(ST + (16 * n + fr) * PB + (k2 * 32 + 8 * fq) * 2), acc);
#pragma unroll
            for (int i = 0; i < 4; ++i) ((LAS float*)(L + OO))[(16 * I + 4 * fq + i) * 68 + 16 * n + fr] = acc[i];
            f32x4 sr = Sreg[nn] * a4;
#pragma unroll
            for (int k2 = 0; k2 < 2; ++k2) sr = HG_MFMA(HG_LD8(KLT + (16 * I + fr) * PB + (k2 * 32 + 8 * fq) * 2), HG_LD8(VT + (16 * n + fr) * PB + (k2 * 32 + 8 * fq) * 2), sr);
            Sreg[nn] = sr;
        }
        __syncthreads();
#pragma unroll
        for (int nn = 0; nn < 2; ++nn) { const int n = 2 * jh + nn;
            *(LAS v2u*)(L + ST + (16 * n + fr) * PB + (16 * I + 4 * fq) * 2) = (v2u){pkbf(Sreg[nn][0], Sreg[nn][1]), pkbf(Sreg[nn][2], Sreg[nn][3])}; }
        {
            const int t = tid >> 3, j8 = tid & 7;
            const f32x4 o0 = *(const LAS f32x4*)(L + OO + (t * 68 + 8 * j8) * 4), o1 = *(const LAS f32x4*)(L + OO + (t * 68 + 8 * j8 + 4) * 4);
            const size_t row = (size_t)b * SEQ + (dir ? 2047 - (64 * c + t) : 64 * c + t);
            float* ofp = OF + row * 256 + h * 64 + 8 * j8;
            *(f32x4*)ofp = o0; *(f32x4*)(ofp + 4) = o1;
        }
    }
    __threadfence();
    __syncthreads();
}
__device__ __forceinline__ void hgrn_combine(const Params& p, int layer, int it) {
    int tid = threadIdx.x; asm volatile("" : "+v"(tid));
    const bfu* Z = (const bfu*)(p.ws + WS_Z); const float* OFf = (const float*)(p.ws + WS_OF); const float* OFb = (const float*)(p.ws + WS_HN); bfu* MIX = (bfu*)(p.ws + WS_MIX);
    const float* gain = p.hgrn_norm + layer * 64;
#pragma unroll 2
    for (int k = 0; k < 16; ++k) {
        const int idx = tid + NTHR * k, r = idx >> 5, cgp = idx & 31; const size_t row = (size_t)it * 256 + r; const int col = 8 * cgp;
        const unsigned long long* pf = (const unsigned long long*)(OFf + row * 256 + col); const unsigned long long* pb = (const unsigned long long*)(OFb + row * 256 + col);
        float sv[8];
#pragma unroll
        for (int q = 0; q < 4; ++q) { const unsigned long long wf = __hip_atomic_load(pf + q, __ATOMIC_RELAXED, __HIP_MEMORY_SCOPE_AGENT), wb = __hip_atomic_load(pb + q, __ATOMIC_RELAXED, __HIP_MEMORY_SCOPE_AGENT);
            sv[2 * q] = __uint_as_float((unsigned)wf) + __uint_as_float((unsigned)wb); sv[2 * q + 1] = __uint_as_float((unsigned)(wf >> 32)) + __uint_as_float((unsigned)(wb >> 32)); }
        float ss = 0.f;
#pragma unroll
        for (int q = 0; q < 8; ++q) ss += sv[q] * sv[q];
        ss += __shfl_xor(ss, 1); ss += __shfl_xor(ss, 2); ss += __shfl_xor(ss, 4);
        const float rs = rsqrtf(ss * (1.f / 64.f) + 1e-6f);
        float zg[8]; unpack8(*(const v4u*)(Z + row * NIN + 2816 + col), zg);
        const f32x4 g0 = *(const f32x4*)(gain + (col & 63)), g1 = *(const f32x4*)(gain + (col & 63) + 4);
#pragma unroll
        for (int q = 0; q < 4; ++q) { sv[q] = sv[q] * rs * g0[q] * (zg[q] * sigmoidf_(zg[q])); sv[q + 4] = sv[q + 4] * rs * g1[q] * (zg[q + 4] * sigmoidf_(zg[q + 4])); }
        *(v4u*)(MIX + row * DM + 768 + col) = pack8(sv);
    }
}
#undef HG_MFMA
#undef HG_LD8
}
__device__ __forceinline__ void phase_mixer(const Params& p, int l, LAS unsigned char* lds, unsigned* ctr) {
    using attn_body::bf16;
    int tid = threadIdx.x; asm volatile("" : "+v"(tid));
    const bf16* Z = (const bf16*)(p.ws + WS_Z); bf16* MIX = (bf16*)(p.ws + WS_MIX);
    const bf16* QA = (const bf16*)(p.ws + WS_QA); const bf16* KA = (const bf16*)(p.ws + WS_KA); const bf16* QB = (const bf16*)(p.ws + WS_QB); const bf16* KB = (const bf16*)(p.ws + WS_KB);
    float lam;
    { const float* lp = p.diff_lambda + l * 128; float s1 = 0.f, s2 = 0.f;
      for (int i = 0; i < 32; ++i) { s1 += lp[i] * lp[32 + i]; s2 += lp[64 + i] * lp[96 + i]; }
      const float lam_init = (l == 0) ? 0.2f : (0.8f - 0.6f * 0.7408182206817179f);
      lam = expf(s1) - expf(s2) + lam_init; }
    const float lam_init = (l == 0) ? 0.2f : (0.8f - 0.6f * 0.7408182206817179f);
    constexpr int N_H = BATCH * 4 * 2, N_B = BATCH * 6 * 8, N_A = BATCH * 6 * 8, N_C = M / 256, N_ITEMS = N_H + N_B + N_A + N_C;
    LAS int* nxt = (LAS int*)(lds + LDS_TOTAL - 16);
    unsigned* hdone = ctr + 16;
    int item = blockIdx.x;
    while (item < N_ITEMS) {
        if (item < N_H) {
            hg::hgrn_scan(lds, p, l, item >> 3, (item >> 1) & 3, item & 1);
            if (tid == 0) __hip_atomic_fetch_add(hdone, 1u, __ATOMIC_RELEASE, __HIP_MEMORY_SCOPE_AGENT);
        } else if (item >= N_H + N_B + N_A) {
            if (tid == 0) { unsigned sp = 0; while (__hip_atomic_load(hdone, __ATOMIC_RELAXED, __HIP_MEMORY_SCOPE_AGENT) < (unsigned)N_H && ++sp < (1u << 24)) __builtin_amdgcn_s_sleep(8);
                __builtin_amdgcn_fence(__ATOMIC_ACQUIRE, "agent"); }
            __syncthreads();
            hg::hgrn_combine(p, l, item - (N_H + N_B + N_A));
        } else {
            attn_body::AttnJob J;
            if (item < N_H + N_B) { const int u = item - N_H, b = u / 48, h = (u % 48) >> 3, qb = u & 7; const size_t r0 = (size_t)b * SEQ, rq = r0 + qb * 256;
                J.Q = QB + rq * 768 + h * 128; J.qp = 768; J.K = KB + r0 * 384 + h * 64; J.kp = 384; J.V = Z + r0 * NIN + 1408 + h * 64; J.vp = NIN;
                J.O = MIX + rq * DM + 384 + h * 64; J.op = DM; J.npass = 2; J.lam = lam; J.gain = p.diff_subln + l * 64; J.oscale = 1.0f - lam_init; }
            else { const int u = item - N_H - N_B, b = u / 48, r = u % 48, kvh = r / 24, gq = (r % 24) >> 3, qb = r & 7, head = kvh * 3 + gq; const size_t r0 = (size_t)b * SEQ, rq = r0 + qb * 256;
                J.Q = QA + rq * 384 + head * 64; J.qp = 384; J.K = KA + r0 * 128 + kvh * 64; J.kp = 128; J.V = Z + r0 * NIN + 512 + kvh * 64; J.vp = NIN;
                J.O = MIX + rq * DM + head * 64; J.op = DM; J.npass = 1; J.lam = 0.f; J.gain = p.diff_subln; J.oscale = 1.f; }
            attn_body::attn_unit<8>(J, (char*)lds);
        }
        if (tid == 0) *nxt = (int)atomicAdd(ctr, 1u) + (int)gridDim.x;
        __syncthreads();
        item = *nxt;
        __syncthreads();
    }
}

typedef const __attribute__((address_space(4))) Params* KParams;
__device__ __forceinline__ Params ldp() {
#if defined(__HIP_DEVICE_COMPILE__)
    KParams k = (KParams)__builtin_amdgcn_kernarg_segment_ptr(); asm volatile("" : "+s"(k)); Params r;
    r.x = k->x; r.c = k->c; r.w_mod = k->w_mod; r.b_mod = k->b_mod; r.w_in = k->w_in; r.a_qk_norm = k->a_qk_norm; r.diff_lambda = k->diff_lambda; r.diff_subln = k->diff_subln; r.hgrn_lb = k->hgrn_lb;
    r.hgrn_norm = k->hgrn_norm; r.w_out = k->w_out; r.w_ff1 = k->w_ff1; r.w_ff2 = k->w_ff2; r.final_norm = k->final_norm; r.out = k->out; r.ws = k->ws; return r;
#else
    return Params{};
#endif
}
__global__ void __launch_bounds__(NTHR, 2) fwd_megakernel(Params p_unused) {
    extern __shared__ __attribute__((aligned(16))) unsigned char lds_raw[];
    LAS unsigned char* lds = (LAS unsigned char*)lds_raw;
    cg::grid_group grid = cg::this_grid();
    { int tid = threadIdx.x; asm volatile("" : "+v"(tid)); const int lane = tid & 63, wave = __builtin_amdgcn_readfirstlane(tid >> 6);
      const Params p = ldp(); phase_prologue(p, lds, tid, lane, wave); }
    grid.sync();
#pragma unroll 1
    for (int l = 0; l < 2; ++l) {
        { int tid = threadIdx.x; asm volatile("" : "+v"(tid)); const int lane = tid & 63, wave = __builtin_amdgcn_readfirstlane(tid >> 6);
          const Params p = ldp(); phase_modnorm((l == 0) ? p.x : p.out, (const float*)(p.ws + WS_MOD) + (size_t)l * BATCH * NMOD, 0, 1024, (bfu*)(p.ws + WS_HN), lane, wave); }
        grid.sync();
        {
            const Params p = ldp();
            pg8::Gemm g{(const bfu*)(p.ws + WS_HN), (const bfu*)(p.ws + WS_WIN) + (size_t)l * NIN * DM, M, NIN, DM}; pg8::StaticOrder S; S.init(M, NIN, (int)gridDim.x, (int)blockIdx.x);
            pg8::EpiBf16<0> E{(bfu*)(p.ws + WS_Z), NIN};
            pg8::gemm_phase<pg8::EpiBf16<0>, pg8::StaticOrder, PG8_ALIGN, PG8_SP2>(lds, g, S, E);
        }
        grid.sync();
        { int tid = threadIdx.x; asm volatile("" : "+v"(tid)); const int lane = tid & 63, wave = __builtin_amdgcn_readfirstlane(tid >> 6);
          const Params p = ldp(); phase_post(p, l, lane, wave); }
        grid.sync();
        { const Params p = ldp(); phase_mixer(p, l, lds, (unsigned*)(p.ws + WS_CTL) + 64 * l); }
        grid.sync();
        {
            const Params p = ldp();
            pg8::Gemm g{(const bfu*)(p.ws + WS_MIX), (const bfu*)(p.ws + WS_WOUT) + (size_t)l * DM * DM, M, DM, DM}; pg8::StaticOrder S; S.init(M, DM, (int)gridDim.x, (int)blockIdx.x);
            pg8::EpiResGate E{(l == 0) ? p.x : p.out, p.out, (const float*)(p.ws + WS_MOD) + (size_t)l * BATCH * NMOD + 2048};
            pg8::gemm_phase<pg8::EpiResGate, pg8::StaticOrder, PG8_ALIGN, PG8_SP2>(lds, g, S, E);
        }
        grid.sync();
        { int tid = threadIdx.x; asm volatile("" : "+v"(tid)); const int lane = tid & 63, wave = __builtin_amdgcn_readfirstlane(tid >> 6);
          const Params p = ldp(); phase_modnorm(p.out, (const float*)(p.ws + WS_MOD) + (size_t)l * BATCH * NMOD, 3072, 4096, (bfu*)(p.ws + WS_HN), lane, wave); }
        grid.sync();
        {
            const Params p = ldp();
            pg8::Gemm g{(const bfu*)(p.ws + WS_HN), (const bfu*)(p.ws + WS_WFF1) + (size_t)l * DFF * DM, M, DFF, DM}; pg8::StaticOrder S; S.init(M, DFF, (int)gridDim.x, (int)blockIdx.x);
            pg8::EpiBf16<2> E{(bfu*)(p.ws + WS_HID), DFF};
            pg8::gemm_phase<pg8::EpiBf16<2>, pg8::StaticOrder, PG8_ALIGN, PG8_SP2>(lds, g, S, E);
        }
        grid.sync();
        {
            const Params p = ldp();
            pg8::Gemm g{(const bfu*)(p.ws + WS_HID), (const bfu*)(p.ws + WS_WFF2) + (size_t)l * DM * DFF, M, DM, DFF}; pg8::StaticOrder S; S.init(M, DM, (int)gridDim.x, (int)blockIdx.x);
            pg8::EpiResGate E{p.out, p.out, (const float*)(p.ws + WS_MOD) + (size_t)l * BATCH * NMOD + 5120};
            pg8::gemm_phase<pg8::EpiResGate, pg8::StaticOrder, PG8_ALIGN, PG8_SP2>(lds, g, S, E);
        }
        grid.sync();
    }
    { int tid = threadIdx.x; asm volatile("" : "+v"(tid)); const int lane = tid & 63, wave = __builtin_amdgcn_readfirstlane(tid >> 6);
      const Params p = ldp(); phase_finalnorm(p.out, p.final_norm, lane, wave); }
}

extern "C" void kernel_launch(void* const* d_in, const int* in_sizes, int n_in, void* d_out, int out_size, void* d_ws, size_t ws_size, hipStream_t stream) {
    static int grid = 0;
    if (grid == 0) {
        if (n_in != 14 || in_sizes[0] != M * DM || out_size != M * DM || ws_size < WS_END) { fprintf(stderr, "kernel_launch: unexpected shapes (n_in %d in0 %d out %d ws %zu)\n", n_in, n_in > 0 ? in_sizes[0] : -1, out_size, ws_size); grid = -1; return; }
        int dev = 0, cus = 0, per_cu = 0;
        hipGetDevice(&dev); hipDeviceGetAttribute(&cus, hipDeviceAttributeMultiprocessorCount, dev);
        if (hipFuncSetAttribute((const void*)fwd_megakernel, hipFuncAttributeMaxDynamicSharedMemorySize, LDS_TOTAL) != hipSuccess) { fprintf(stderr, "kernel_launch: hipFuncSetAttribute failed\n"); grid = -1; return; }
        if (hipOccupancyMaxActiveBlocksPerMultiprocessor(&per_cu, (const void*)fwd_megakernel, NTHR, LDS_TOTAL) != hipSuccess || per_cu < 1) { fprintf(stderr, "kernel_launch: occupancy query says %d\n", per_cu); per_cu = 1; }
        (void)hipGetLastError();
        grid = cus * 1;
        (void)per_cu;
    }
    if (grid < 0) return;
    hipMemsetAsync((char*)d_ws + WS_CTL, 0, CTL_ZERO_BYTES, stream);
    Params p{};
    p.x = (const float*)d_in[0]; p.c = (const float*)d_in[1]; p.w_mod = (const float*)d_in[2]; p.b_mod = (const float*)d_in[3]; p.w_in = (const float*)d_in[4];
    p.a_qk_norm = (const float*)d_in[5]; p.diff_lambda = (const float*)d_in[6]; p.diff_subln = (const float*)d_in[7]; p.hgrn_lb = (const float*)d_in[8]; p.hgrn_norm = (const float*)d_in[9];
    p.w_out = (const float*)d_in[10]; p.w_ff1 = (const float*)d_in[11]; p.w_ff2 = (const float*)d_in[12]; p.final_norm = (const float*)d_in[13];
    p.out = (float*)d_out; p.ws = (unsigned char*)d_ws;
    void* args[] = {&p};
    hipError_t e = hipLaunchCooperativeKernel((const void*)fwd_megakernel, dim3(grid), dim3(NTHR), args, LDS_TOTAL, stream);
    if (e != hipSuccess) fprintf(stderr, "cooperative launch failed: %s (grid %d)\n", hipGetErrorString(e), grid);
}
```

```cpp
#include <hip/hip_runtime.h>
#include <hip/hip_cooperative_groups.h>
#include <hip/hip_bf16.h>
#include <cstdio>
#include <cstdint>
#include <cmath>
namespace cg = cooperative_groups;
namespace pg8 {
#define PG8_LAS __attribute__((address_space(3)))
typedef unsigned short bf16_t;
typedef short bf16x8 __attribute__((ext_vector_type(8)));
typedef float f32x4 __attribute__((ext_vector_type(4)));
typedef unsigned u32x4 __attribute__((ext_vector_type(4)));
constexpr int BM = 256, BK = 64, HALF = 128, HTB = HALF * BK * 2  , STAGE_BYTES = 8 * HTB, NXCD = 8, WGM = 8;

__host__ __device__ __forceinline__ int lds_byte(int r, int c) { const int st = (r >> 4) * 2 + (c >> 5), rr = r & 15, cc = c & 31, ob = rr * 64 + cc * 2; return st * 1024 + (ob ^ (((ob >> 9) & 1) << 5)); }
__host__ __device__ __forceinline__ void stage_rc(int b, int& R, int& C) { const int st = b / 1024, sb = b % 1024, swz = sb ^ (((sb >> 9) & 1) << 5); R = (st >> 1) * 16 + swz / 64; C = (st & 1) * 32 + (swz % 64) / 2; }
__host__ __device__ __forceinline__ int perm32(int rho) { const int n = rho >> 4, i = rho & 15; return 8 * (i >> 2) + 4 * n + (i & 3); }

struct Unit { int pm, pn; };
struct Gemm { const bf16_t* A; const bf16_t* Bt; int M, N, K; };

struct StaticOrder {
    int nM, nN, nwg, G, c;
    __host__ __device__ void init(int M, int N, int G_, int c_) { nM = M / BM; nN = N / BM; nwg = nM * nN; G = G_; c = c_; }
    __host__ __device__ bool next(int i, Unit& u) const {
        const long L = (long)i * G + c; if (L >= nwg) return false;
        int wgid = (int)L; { const int q = nwg / NXCD, r = nwg % NXCD, xcd = wgid % NXCD, off = wgid / NXCD; wgid = (xcd < r ? xcd * (q + 1) : r * (q + 1) + (xcd - r) * q) + off; }
        const int nig = WGM * nN, gid = wgid / nig, fm = gid * WGM, gsz = (nM - fm) < WGM ? (nM - fm) : WGM;
        u.pm = fm + ((wgid % nig) % gsz); u.pn = (wgid % nig) / gsz; return true;
    }
    __device__ __forceinline__ void a_ready(const Unit&) const {}
    __device__ __forceinline__ void done(const Unit&) const {}
};

__device__ __forceinline__ unsigned cvt_pk_bf16(float lo, float hi) { unsigned r; asm volatile("v_cvt_pk_bf16_f32 %0, %1, %2" : "=v"(r) : "v"(lo), "v"(hi)); return r; }
template <int ACT> struct EpiBf16 {
    static constexpr bool PERM = true, AFTER_DRAIN = false;
    bf16_t* O; int ldc;
    __device__ __forceinline__ void operator()(const f32x4 (&acc)[2][2][4][2], const Unit& u, int wr, int wc, int fr, int fq) const {
        const int row0 = u.pm * BM + wr * 64 + fr; const int col0 = u.pn * BM + wc * 32 + 8 * fq;
#pragma unroll
        for (int ai = 0; ai < 2; ++ai)
#pragma unroll
            for (int m = 0; m < 4; ++m) { bf16_t* rowp = O + (size_t)(row0 + ai * HALF + m * 16) * ldc + col0;
#pragma unroll
                for (int bj = 0; bj < 2; ++bj) { f32x4 v0 = acc[ai][bj][m][0], v1 = acc[ai][bj][m][1];
                    if (ACT == 2) {
#pragma unroll
                        for (int e = 0; e < 4; ++e) { const float a = fmaxf(v0[e], 0.f), b = fmaxf(v1[e], 0.f); v0[e] = a * a; v1[e] = b * b; } }
                    u32x4 w; w.x = cvt_pk_bf16(v0[0], v0[1]); w.y = cvt_pk_bf16(v0[2], v0[3]); w.z = cvt_pk_bf16(v1[0], v1[1]); w.w = cvt_pk_bf16(v1[2], v1[3]);
                    *(u32x4*)(rowp + bj * HALF) = w; } }
    }
};
struct EpiResGate {
    static constexpr bool PERM = false, AFTER_DRAIN = false;
    const float* xin; float* out; const float* gate;
    __device__ __forceinline__ void operator()(const f32x4 (&acc)[2][2][4][2], const Unit& u, int wr, int wc, int fr, int fq) const {
        const int b = (u.pm * BM) >> 11; const int col0 = u.pn * BM + wc * 32 + 4 * fq;
        f32x4 gv[2][2];
#pragma unroll
        for (int bj = 0; bj < 2; ++bj)
#pragma unroll
            for (int n = 0; n < 2; ++n) gv[bj][n] = *(const f32x4*)(gate + (size_t)b * 6144 + col0 + bj * HALF + n * 16);
#pragma unroll
        for (int ai = 0; ai < 2; ++ai)
#pragma unroll
            for (int m = 0; m < 4; ++m) { const size_t off = (size_t)(u.pm * BM + ai * HALF + wr * 64 + m * 16 + fr) * 1024 + col0;
#pragma unroll
                for (int bj = 0; bj < 2; ++bj)
#pragma unroll
                    for (int n = 0; n < 2; ++n) { const f32x4 xv = *(const f32x4*)(xin + off + bj * HALF + n * 16);
                        *(f32x4*)(out + off + bj * HALF + n * 16) = xv + gv[bj][n] * acc[ai][bj][m][n]; }
                asm volatile("" ::: "memory"); }
    }
};
template <class Epi, class Sched, bool ALIGN_EPI = false, bool SP2 = false>
__device__ __forceinline__ void gemm_phase(PG8_LAS unsigned char* lds, const Gemm g, const Sched& S, const Epi& E) {
    int tid_ = threadIdx.x; asm volatile("" : "+v"(tid_));
    const int tid = tid_, wid = __builtin_amdgcn_readfirstlane(tid >> 6), lane = tid & 63, wr = wid >> 2, wc = wid & 3, fr = lane & 15, fq = lane >> 4;
    const int K = g.K, nt = K / BK;
    unsigned voffA[2], voffB[2];
#pragma unroll
    for (int i = 0; i < 2; ++i) { int R, C; stage_rc(tid * 16 + i * 8192, R, C); const int Rb = Epi::PERM ? ((R & ~31) + perm32(R & 31)) : R;
        voffA[i] = (unsigned)(R * K + C) * 2u; voffB[i] = (unsigned)(Rb * K + C) * 2u; }
    const size_t kstep = (size_t)(BK * 2);
    const size_t hstep = (size_t)HALF * K * 2;
    const size_t tstep = 2 * hstep;
    const unsigned ldsw = (unsigned)wid * 1024u;
    const int aoff = lds_byte(wr * 64 + fr, fq * 8), boff = lds_byte(wc * 32 + fr, fq * 8);
#define PG8_SA(b, h) (((b) * 2 + (h)) * HTB)
#define PG8_SB(b, h) ((4 + (b) * 2 + (h)) * HTB)
#define PG8_STAGE(bufoff, gbase, voff) do { _Pragma("unroll") for (int _i = 0; _i < 2; ++_i) \
        __builtin_amdgcn_global_load_lds((const unsigned*)((const char*)(gbase) + (voff)[_i]), (PG8_LAS unsigned*)(lds + (bufoff) + ldsw + _i * 8192), 16, 0, 0); } while (0)
#define PG8_LDA(dst, b, h) do { _Pragma("unroll") for (int m = 0; m < 4; ++m) _Pragma("unroll") for (int k = 0; k < 2; ++k) dst[m][k] = *(const PG8_LAS bf16x8*)(lds + PG8_SA(b, h) + aoff + m * 2048 + k * 1024); } while (0)
#define PG8_LDB(dst, b, h) do { _Pragma("unroll") for (int n = 0; n < 2; ++n) _Pragma("unroll") for (int k = 0; k < 2; ++k) dst[n][k] = *(const PG8_LAS bf16x8*)(lds + PG8_SB(b, h) + boff + n * 2048 + k * 1024); } while (0)
#define PG8_MMA(ai, bj, At, Bt) do { __builtin_amdgcn_s_setprio(1); _Pragma("unroll") for (int m = 0; m < 4; ++m) _Pragma("unroll") for (int n = 0; n < 2; ++n) _Pragma("unroll") for (int k = 0; k < 2; ++k) \
        acc[ai][bj][m][n] = __builtin_amdgcn_mfma_f32_16x16x32_bf16(Bt[n][k], At[m][k], acc[ai][bj][m][n], 0, 0, 0); __builtin_amdgcn_s_setprio(0); } while (0)
#define PG8_WAIT_V(n) asm volatile("s_waitcnt vmcnt(" #n ")" ::: "memory")
#define PG8_WAIT_L(n) asm volatile("s_waitcnt lgkmcnt(" #n ")" ::: "memory")
#define PG8_BAR __builtin_amdgcn_s_barrier()
#define PG8_SCHED __builtin_amdgcn_sched_barrier(0)
    Unit cur, nxt; int ui = 0;
    if (!S.next(0, cur)) return;
    f32x4 acc[2][2][4][2];
#pragma unroll
    for (int a = 0; a < 2; ++a)
#pragma unroll
        for (int b = 0; b < 2; ++b)
#pragma unroll
            for (int m = 0; m < 4; ++m)
#pragma unroll
                for (int n = 0; n < 2; ++n) acc[a][b][m][n] = (f32x4){0.f, 0.f, 0.f, 0.f};
    bf16x8 At[4][2], B0[2][2], B1[2][2];
    const char* cA = (const char*)g.A + (size_t)cur.pm * tstep; const char* cB = (const char*)g.Bt + (size_t)cur.pn * tstep;
    S.a_ready(cur);
    if constexpr (SP2) {
        PG8_STAGE(PG8_SB(0, 0), cB, voffB); PG8_STAGE(PG8_SB(0, 1), cB + hstep, voffB); PG8_STAGE(PG8_SA(0, 0), cA, voffA); PG8_STAGE(PG8_SA(0, 1), cA + hstep, voffA);
        if (wr == 1) PG8_BAR;
        PG8_WAIT_V(2); PG8_BAR;
        PG8_STAGE(PG8_SB(1, 0), cB + kstep, voffB); PG8_STAGE(PG8_SA(1, 0), cA + kstep, voffA); PG8_STAGE(PG8_SB(1, 1), cB + hstep + kstep, voffB);
        PG8_WAIT_V(6); PG8_BAR;
    } else {
        PG8_STAGE(PG8_SB(0, 0), cB, voffB); PG8_STAGE(PG8_SA(0, 0), cA, voffA); PG8_STAGE(PG8_SB(0, 1), cB + hstep, voffB); PG8_STAGE(PG8_SA(0, 1), cA + hstep, voffA);
        if (wr == 1) PG8_BAR;
        PG8_WAIT_V(4); PG8_BAR;
        PG8_STAGE(PG8_SB(1, 0), cB + kstep, voffB); PG8_STAGE(PG8_SA(1, 0), cA + kstep, voffA); PG8_STAGE(PG8_SB(1, 1), cB + hstep + kstep, voffB);
        PG8_WAIT_V(6); PG8_BAR;
    }
    for (;;) {
        const bool has_next = S.next(ui + 1, nxt);
        const char* nA = has_next ? (const char*)g.A + (size_t)nxt.pm * tstep : cA; const char* nB = has_next ? (const char*)g.Bt + (size_t)nxt.pn * tstep : cB;
        for (int t = 0; t < nt; t += 2) {
            const bool last = (t == nt - 2);
            const char* a1 = cA + (size_t)(t + 1) * kstep;
            const char* a2 = last ? nA : cA + (size_t)(t + 2) * kstep; const char* b2 = last ? nB : cB + (size_t)(t + 2) * kstep;
            const char* a3 = a2 + kstep; const char* b3 = b2 + kstep;
            if (last && has_next) S.a_ready(nxt);
            if constexpr (SP2) {
            PG8_LDB(B0, 0, 0); PG8_LDB(B1, 0, 1); PG8_SCHED; PG8_LDA(At, 0, 0); PG8_STAGE(PG8_SA(1, 1), a1 + hstep, voffA);
            PG8_WAIT_V(8); PG8_WAIT_L(0); PG8_BAR; PG8_MMA(0, 0, At, B0); PG8_MMA(0, 1, At, B1); PG8_BAR; PG8_SCHED;
            PG8_LDA(At, 0, 1); PG8_STAGE(PG8_SB(0, 0), b2, voffB); PG8_STAGE(PG8_SB(0, 1), b2 + hstep, voffB); PG8_STAGE(PG8_SA(0, 0), a2, voffA);
            PG8_WAIT_V(8); PG8_WAIT_L(0); PG8_BAR; PG8_MMA(1, 0, At, B0); PG8_MMA(1, 1, At, B1); PG8_BAR; PG8_SCHED;
            PG8_LDB(B0, 1, 0); PG8_LDB(B1, 1, 1); PG8_SCHED; PG8_LDA(At, 1, 0); PG8_STAGE(PG8_SA(0, 1), a2 + hstep, voffA);
            PG8_WAIT_V(8); PG8_WAIT_L(0); PG8_BAR; PG8_MMA(0, 0, At, B0); PG8_MMA(0, 1, At, B1); PG8_BAR; PG8_SCHED;
            PG8_LDA(At, 1, 1); PG8_STAGE(PG8_SB(1, 0), b3, voffB); PG8_STAGE(PG8_SB(1, 1), b3 + hstep, voffB); PG8_STAGE(PG8_SA(1, 0), a3, voffA);
            PG8_WAIT_V(8); PG8_WAIT_L(0); PG8_BAR; PG8_MMA(1, 0, At, B0); PG8_MMA(1, 1, At, B1); PG8_BAR; PG8_SCHED;
            } else {
            PG8_LDB(B0, 0, 0); PG8_SCHED; PG8_LDA(At, 0, 0); PG8_STAGE(PG8_SA(1, 1), a1 + hstep, voffA);
            PG8_WAIT_L(8); PG8_BAR; PG8_WAIT_L(0); PG8_MMA(0, 0, At, B0); PG8_BAR; PG8_SCHED;
            PG8_LDB(B1, 0, 1); PG8_STAGE(PG8_SB(0, 0), b2, voffB);
            PG8_BAR; PG8_WAIT_L(0); PG8_MMA(0, 1, At, B1); PG8_BAR;
            PG8_LDA(At, 0, 1); PG8_STAGE(PG8_SA(0, 0), a2, voffA);
            PG8_BAR; PG8_WAIT_L(0); PG8_MMA(1, 0, At, B0); PG8_BAR; PG8_SCHED;
            PG8_STAGE(PG8_SB(0, 1), b2 + hstep, voffB);
            PG8_WAIT_V(6); PG8_BAR; PG8_MMA(1, 1, At, B1); PG8_BAR;
            PG8_LDB(B0, 1, 0); PG8_SCHED; PG8_LDA(At, 1, 0); PG8_STAGE(PG8_SA(0, 1), a2 + hstep, voffA);
            PG8_WAIT_L(8); PG8_BAR; PG8_WAIT_L(0); PG8_MMA(0, 0, At, B0); PG8_BAR; PG8_SCHED;
            PG8_LDB(B1, 1, 1); PG8_STAGE(PG8_SB(1, 0), b3, voffB);
            PG8_BAR; PG8_WAIT_L(0); PG8_MMA(0, 1, At, B1); PG8_BAR;
            PG8_LDA(At, 1, 1); PG8_STAGE(PG8_SA(1, 0), a3, voffA);
            PG8_BAR; PG8_WAIT_L(0); PG8_MMA(1, 0, At, B0); PG8_BAR; PG8_SCHED;
            PG8_STAGE(PG8_SB(1, 1), b3 + hstep, voffB);
            PG8_WAIT_V(6); PG8_BAR; PG8_MMA(1, 1, At, B1); PG8_BAR;
            }
        }
        if constexpr (ALIGN_EPI) { if (wr == 0) PG8_BAR; }
        if constexpr (!Epi::AFTER_DRAIN) { E(acc, cur, wr, wc, fr, fq); S.done(cur); }
        if (!has_next) break;
#pragma unroll
        for (int a = 0; a < 2; ++a)
#pragma unroll
            for (int b = 0; b < 2; ++b)
#pragma unroll
                for (int m = 0; m < 4; ++m)
#pragma unroll
                    for (int n = 0; n < 2; ++n) acc[a][b][m][n] = (f32x4){0.f, 0.f, 0.f, 0.f};
        cur = nxt; cA = nA; cB = nB; ++ui;
        if constexpr (ALIGN_EPI) { if (wr == 1) PG8_BAR; }
    }
    PG8_WAIT_V(0);
    if constexpr (!ALIGN_EPI) { if (wr == 0) PG8_BAR; }
    PG8_BAR;
    if constexpr (Epi::AFTER_DRAIN) { E.fused(acc, cur, wr, wc, fr, fq, lds, wid, lane); S.done(cur); }
#undef PG8_SA
#undef PG8_SB
#undef PG8_STAGE
#undef PG8_LDA
#undef PG8_LDB
#undef PG8_MMA
#undef PG8_WAIT_V
#undef PG8_WAIT_L
#undef PG8_BAR
#undef PG8_SCHED
}
}

#ifndef PG8_SP2
#define PG8_SP2 true
#endif
#ifndef PG8_ALIGN
#define PG8_ALIGN true
#endif
#include <hip/hip_bf16.h>
#include <cmath>
namespace attn_body {
using bf16=__hip_bfloat16;
using bf16x8=__attribute__((ext_vector_type(8)))short;
using s16x4=__attribute__((ext_vector_type(4)))short;
using f32x16=__attribute__((ext_vector_type(16)))float;
using u32x4=__attribute__((ext_vector_type(4)))unsigned;
constexpr int SEQ=2048,D=64;
constexpr int NW=8,QBLK=32,QB=QBLK*NW,KVBLK=64,NQB=SEQ/QB;
__device__ __forceinline__ int crow(int r,int hi){return (r&3)+8*(r>>2)+4*hi;}
#define SBAR() __builtin_amdgcn_sched_barrier(0)
constexpr int NSLOT=3, SLOTB=8192;
constexpr int LDS_K=0, LDS_V=NSLOT*SLOTB, LDS_WS=2*NSLOT*SLOTB, LDS_OST=LDS_WS+NW*64*4, LDS_STASH=LDS_OST+NW*4096, LDS_BYTES=LDS_STASH+NW*8192;
constexpr float LOG2E=1.4426950408889634f;
__device__ __forceinline__ void glds16(const void*gsrc,unsigned lds_dst){unsigned keep;
  asm volatile("s_mov_b32 %0, m0\n\ts_mov_b32 m0, %2\n\ts_nop 0\n\tglobal_load_lds_dwordx4 %1, off\n\ts_mov_b32 m0, %0":"=&s"(keep):"v"(gsrc),"s"(lds_dst):"memory");}
__device__ __forceinline__ float max3f(float a,float b,float c){float r;asm("v_max3_f32 %0, %1, %2, %3":"=v"(r):"v"(a),"v"(b),"v"(c));return r;}
__device__ __forceinline__ float max2f(float a,float b){float r;asm("v_max_f32_e32 %0, %1, %2":"=v"(r):"v"(a),"v"(b));return r;}
__device__ __forceinline__ float fadd_s(float a,float b){float r;asm("v_add_f32_e32 %0, %1, %2":"=v"(r):"v"(a),"v"(b));return r;}
__device__ __forceinline__ float fsub_s(float a,float b){float r;asm("v_sub_f32_e32 %0, %1, %2":"=v"(r):"v"(a),"v"(b));return r;}
typedef float f32x2_t __attribute__((ext_vector_type(2))); typedef __bf16 bf16x2_t __attribute__((ext_vector_type(2)));
__device__ __forceinline__ unsigned cvtpk_s(float lo,float hi){f32x2_t v={lo,hi};bf16x2_t b=__builtin_convertvector(v,bf16x2_t);return __builtin_bit_cast(unsigned,b);}
#define WAIT_BAR(N) asm volatile("s_waitcnt vmcnt(" #N ") lgkmcnt(0)\n\ts_barrier":::"memory")

__device__ __forceinline__ void qkt(f32x16&p0,f32x16&p1,const char*Kslot,const bf16x8*qr,const f32x16&negm,int r32,int hi){
  const char*kb=Kslot+hi*1024+r32*16;
  #pragma unroll
  for(int d0=0;d0<4;++d0){
    const bf16x8 b0=*reinterpret_cast<const bf16x8*>(kb+d0*2048);
    const bf16x8 b1=*reinterpret_cast<const bf16x8*>(kb+d0*2048+512);
    if(d0==0){p0=__builtin_amdgcn_mfma_f32_32x32x16_bf16(b0,qr[0],negm,0,0,0);p1=__builtin_amdgcn_mfma_f32_32x32x16_bf16(b1,qr[0],negm,0,0,0);}
    else{p0=__builtin_amdgcn_mfma_f32_32x32x16_bf16(b0,qr[d0],p0,0,0,0);p1=__builtin_amdgcn_mfma_f32_32x32x16_bf16(b1,qr[d0],p1,0,0,0);}}
}
typedef __attribute__((address_space(3))) const char* lds_cptr;
typedef short v4i16_t __attribute__((ext_vector_type(4)));
__device__ __forceinline__ void kload8(bf16x8*kf,lds_cptr kp){
  kf[0]=*(const __attribute__((address_space(3))) bf16x8*)(kp);      kf[1]=*(const __attribute__((address_space(3))) bf16x8*)(kp+512);
  kf[2]=*(const __attribute__((address_space(3))) bf16x8*)(kp+2048); kf[3]=*(const __attribute__((address_space(3))) bf16x8*)(kp+2560);
  kf[4]=*(const __attribute__((address_space(3))) bf16x8*)(kp+4096); kf[5]=*(const __attribute__((address_space(3))) bf16x8*)(kp+4608);
  kf[6]=*(const __attribute__((address_space(3))) bf16x8*)(kp+6144); kf[7]=*(const __attribute__((address_space(3))) bf16x8*)(kp+6656);
}
__device__ __forceinline__ void kload2(bf16x8*kf,lds_cptr kp,int j){ kf[2*j]=*(const __attribute__((address_space(3))) bf16x8*)(kp+j*2048); kf[2*j+1]=*(const __attribute__((address_space(3))) bf16x8*)(kp+j*2048+512); }
__device__ __forceinline__ s16x4 vtr(lds_cptr p){ return __builtin_bit_cast(s16x4,__builtin_amdgcn_ds_read_tr16_b64_v4i16((__attribute__((address_space(3))) v4i16_t*)p)); }
__device__ __forceinline__ float rowmax(const f32x16&p0,const f32x16&p1){
  float a=max3f(p0[0],p0[1],p1[0]),b=max3f(p0[2],p0[3],p1[1]);a=max3f(a,p1[2],p1[3]);
  #pragma unroll
  for(int r=4;r<16;r+=4){a=max3f(a,p0[r],p0[r+1]);b=max3f(b,p0[r+2],p0[r+3]);a=max3f(a,p1[r],p1[r+1]);b=max3f(b,p1[r+2],p1[r+3]);}
  const float m=max2f(a,b);
  auto rr=__builtin_amdgcn_permlane32_swap(__float_as_uint(m),__float_as_uint(m),false,false);
  return max2f(__uint_as_float(rr[0]),__uint_as_float(rr[1]));
}
__device__ __forceinline__ void pv(f32x16*o,int vb,bf16x8 pa0,bf16x8 pa1,bf16x8 pa2,bf16x8 pa3){
  #pragma unroll
  for(int d0=0;d0<2;++d0){s16x4 lo[4],hi[4];
    #pragma unroll
    for(int ks=0;ks<4;++ks){
      asm volatile("ds_read_b64_tr_b16 %0,%1 offset:%c2":"=&v"(lo[ks]):"v"(vb),"i"(d0*4096+ks*1024):"memory");
      asm volatile("ds_read_b64_tr_b16 %0,%1 offset:%c2":"=&v"(hi[ks]):"v"(vb),"i"(d0*4096+ks*1024+512):"memory");}
    asm volatile("s_waitcnt lgkmcnt(0)":::"memory");SBAR();
    #define PK(k) (bf16x8){lo[k][0],lo[k][1],lo[k][2],lo[k][3],hi[k][0],hi[k][1],hi[k][2],hi[k][3]}
    o[d0]=__builtin_amdgcn_mfma_f32_32x32x16_bf16(pa0,PK(0),o[d0],0,0,0);
    o[d0]=__builtin_amdgcn_mfma_f32_32x32x16_bf16(pa1,PK(1),o[d0],0,0,0);
    o[d0]=__builtin_amdgcn_mfma_f32_32x32x16_bf16(pa2,PK(2),o[d0],0,0,0);
    o[d0]=__builtin_amdgcn_mfma_f32_32x32x16_bf16(pa3,PK(3),o[d0],0,0,0);
    #undef PK
  }
}
struct AttnJob { const bf16* Q; int qp; const bf16* K; int kp; const bf16* V; int vp; bf16* O; int op; int npass; float lam; const float* gain; float oscale; };
typedef float f32x4a __attribute__((ext_vector_type(4)));
template<int THRL> __device__ __forceinline__ void attn_unit(const AttnJob& J,char*shm){
 for(int pass=0;pass<J.npass;++pass){
  int tid_=threadIdx.x; asm volatile("":"+v"(tid_)); const int tid=tid_,lane=tid&63,r32=lane&31,hi=lane>>5; const int wid=__builtin_amdgcn_readfirstlane(tid>>6);
  const bf16*Qw=J.Q+(long)(wid*QBLK)*J.qp+pass*64;
  const bf16*Kh=J.K,*Vh=J.V;
  const unsigned lds0=(unsigned)(uintptr_t)shm;
  float*wsf=(float*)(shm+LDS_WS)+wid*64;
  const bf16*ksrc=Kh+(long)lane*J.kp+wid*8;
  const bf16*vsrc=Vh+(long)(16*(wid&3)+(lane>>2))*J.vp+(wid>>2)*32+(lane&3)*8;
  const unsigned kdst=lds0+LDS_K+wid*1024, vdst=lds0+LDS_V+wid*1024;
  #define DMA_K(t,slot) glds16(ksrc+(long)(t)*KVBLK*J.kp,(unsigned)__builtin_amdgcn_readfirstlane(kdst+(slot)))
  #define DMA_V(t,slot) glds16(vsrc+(long)(t)*KVBLK*J.vp,(unsigned)__builtin_amdgcn_readfirstlane(vdst+(slot)))
  const int vb0=(int)(lds0+LDS_V)+((lane>>4)&1)*32+(lane&3)*8+(4*hi+((lane&15)>>2))*64;
  const char*Kbase=shm+LDS_K; bf16x8 kf[8];
  const lds_cptr shm3=(lds_cptr)shm; const lds_cptr kp0=shm3+LDS_K+hi*1024+r32*16; const lds_cptr vp0=shm3+LDS_V+((lane>>4)&1)*32+(lane&3)*8+(4*hi+((lane&15)>>2))*64;
  constexpr int NT=SEQ/KVBLK;
  DMA_K(0,0);DMA_V(0,0);DMA_K(1,SLOTB);
  bf16x8 qr[4];
  #pragma unroll
  for(int d0=0;d0<4;++d0)qr[d0]=*reinterpret_cast<const bf16x8*>(&Qw[(long)r32*J.qp+d0*16+hi*8]);
  float mhat=0.f,l_reg=0.f;f32x16 o[2];o[0]=f32x16{};o[1]=f32x16{};f32x16 negm=f32x16{};asm volatile("":"+v"(negm));
  #define CMASK(P0,P1,t) do{}while(0)
  bool resc=false;
  #define START(P0,P1) do{ const float rm=rowmax(P0,P1); resc=false; \
    { const float dl=rm; mhat=fadd_s(mhat,dl); \
      _Pragma("unroll") for(int r=0;r<16;++r){P0[r]=fsub_s(P0[r],dl);P1[r]=fsub_s(P1[r],dl);} \
      _Pragma("unroll") for(int r=0;r<16;++r)negm[r]=-mhat; asm volatile("":"+v"(negm)); } \
    _Pragma("unroll") for(int r=0;r<16;++r)P0[r]=__builtin_amdgcn_exp2f(P0[r]); }while(0)
  #define RESC() do{ if(resc){ asm volatile("s_waitcnt lgkmcnt(0)":::"memory"); \
      _Pragma("unroll") for(int d_=0;d_<2;++d_) _Pragma("unroll") for(int r=0;r<16;++r)o[d_][r]*=wsf[crow(r,hi)]; } }while(0)
  f32x16 pA0,pA1,pB0,pB1;
  int sl_prev=0,sl_cur=0,sl_next=SLOTB;
  #define ROT() do{sl_prev=sl_cur;sl_cur=sl_next;sl_next=(sl_next==(NSLOT-1)*SLOTB)?0:sl_next+SLOTB;}while(0)
  DMA_K(2,2*SLOTB);
  WAIT_BAR(3);
  qkt(pA0,pA1,Kbase,qr,negm,r32,hi);asm volatile("s_nop 15\n\ts_nop 7":"+v"(pA0),"+v"(pA1));CMASK(pA0,pA1,0);
  START(pA0,pA1);
  _Pragma("unroll") for(int r=0;r<16;++r)pA1[r]=__builtin_amdgcn_exp2f(pA1[r]);
  WAIT_BAR(0);
  DMA_K(3,0);DMA_V(1,SLOTB);
  ROT();
  kload8(kf,kp0+sl_cur);
  WAIT_BAR(2);
  s16x4 vlo[8],vhi[8]; u32x4 pw0,pw1,pw2,pw3;
  #define PKW(P,B) cvtpk_s(P[B],P[B+1])
  #define PAF(k) __builtin_bit_cast(bf16x8,pw##k)
  #define VFR(i) (bf16x8){vlo[i][0],vlo[i][1],vlo[i][2],vlo[i][3],vhi[i][0],vhi[i][1],vhi[i][2],vhi[i][3]}
  #define PIN(x) asm volatile("":"+v"(x))
  #define MX3(a,b,c) __builtin_fmaxf(__builtin_fmaxf((a),(b)),(c))
  #define GAPA(MF,A0,A1,A2,A3,W0,W1,PW) do{ MF; sacc+=A0; sacc+=A1; sacc+=A2; sacc+=A3; PIN(sacc); W0; W1; PIN(PW); SBAR(); }while(0)
  #define EX(v) __builtin_amdgcn_exp2f(v)
  #define GAPB(MF,X,B) do{ MF; X[B]=EX(X[B]); X[B+1]=EX(X[B+1]); X[B+2]=EX(X[B+2]); X[B+3]=EX(X[B+3]); PIN(X); SBAR(); }while(0)
  #define VRD(i) do{ vlo[i]=vtr(vp_+(((i)>>2)*4096+((i)&3)*1024)); vhi[i]=vtr(vp_+(((i)>>2)*4096+((i)&3)*1024+512)); }while(0)
  #define KRD(G,j) do{ if(G){ kload2(kf,kp0+sl_next,j); SBAR(); } }while(0)
  #define STEP(C0,C1,P0,P1,t,GK,GV,GL) do{ SBAR(); \
    const lds_cptr vp_=vp0+sl_prev; \
    VRD(0); SBAR(); float sacc=(P0[0]+P0[1]); \
    GAPA(C0=__builtin_amdgcn_mfma_f32_32x32x16_bf16(kf[0],qr[0],negm,0,0,0), P0[2],P0[3],P0[4],P0[5],     pw0[0]=PKW(P0,0), pw0[1]=PKW(P0,2), pw0); \
    VRD(4); SBAR(); GAPA(C1=__builtin_amdgcn_mfma_f32_32x32x16_bf16(kf[1],qr[0],negm,0,0,0), P0[6],P0[7],P0[8],P0[9],     pw0[2]=PKW(P0,4), pw0[3]=PKW(P0,6), pw0); \
    VRD(1); SBAR(); GAPA(C0=__builtin_amdgcn_mfma_f32_32x32x16_bf16(kf[2],qr[1],C0,0,0,0),   P0[10],P0[11],P0[12],P0[13], pw1[0]=PKW(P0,8), pw1[1]=PKW(P0,10), pw1); \
    VRD(5); SBAR(); GAPA(C1=__builtin_amdgcn_mfma_f32_32x32x16_bf16(kf[3],qr[1],C1,0,0,0),   P0[14],P0[15],P1[0],P1[1],   pw1[2]=PKW(P0,12),pw1[3]=PKW(P0,14), pw1); \
    VRD(2); SBAR(); GAPA(C0=__builtin_amdgcn_mfma_f32_32x32x16_bf16(kf[4],qr[2],C0,0,0,0),   P1[2],P1[3],P1[4],P1[5],     pw2[0]=PKW(P1,0), pw2[1]=PKW(P1,2), pw2); \
    VRD(6); SBAR(); GAPA(C1=__builtin_amdgcn_mfma_f32_32x32x16_bf16(kf[5],qr[2],C1,0,0,0),   P1[6],P1[7],P1[8],P1[9],     pw2[2]=PKW(P1,4), pw2[3]=PKW(P1,6), pw2); \
    VRD(3); SBAR(); GAPA(C0=__builtin_amdgcn_mfma_f32_32x32x16_bf16(kf[6],qr[3],C0,0,0,0),   P1[10],P1[11],P1[12],P1[13], pw3[0]=PKW(P1,8), pw3[1]=PKW(P1,10), pw3); \
    VRD(7); SBAR(); GAPA(C1=__builtin_amdgcn_mfma_f32_32x32x16_bf16(kf[7],qr[3],C1,0,0,0),   P1[14],P1[15],0.f,0.f,       pw3[2]=PKW(P1,12),pw3[3]=PKW(P1,14), pw3); \
    l_reg+=sacc; \
    if(GK){DMA_K((t)+3,sl_cur);} if(GV){DMA_V((t)+1,sl_next);} \
    CMASK(C0,C1,t); \
    { float a=MX3(C0[0],C0[1],C1[0]),b=MX3(C0[2],C0[3],C1[1]); a=MX3(a,C1[2],C1[3]); \
      _Pragma("unroll") for(int r=4;r<16;r+=4){a=MX3(a,C0[r],C0[r+1]);b=MX3(b,C0[r+2],C0[r+3]);a=MX3(a,C1[r],C1[r+1]);b=MX3(b,C1[r+2],C1[r+3]);} \
      float rm=__builtin_fmaxf(a,b); { auto rr=__builtin_amdgcn_permlane32_swap(__float_as_uint(rm),__float_as_uint(rm),false,false); rm=__builtin_fmaxf(__uint_as_float(rr[0]),__uint_as_float(rr[1])); } \
      resc=false; \
      if(__builtin_expect(__any(rm>(float)THRL),0)){ const float dl=__builtin_fmaxf(rm,0.f); mhat+=dl; \
        _Pragma("unroll") for(int r=0;r<16;++r){C0[r]-=dl;C1[r]-=dl;} \
        _Pragma("unroll") for(int r=0;r<16;++r)negm[r]=-mhat; asm volatile("":"+v"(negm)); \
        const float f=__builtin_amdgcn_exp2f(-dl); l_reg*=f; if(hi==0)wsf[r32]=f; resc=true; } } \
    SBAR(); \
    GAPB(o[0]=__builtin_amdgcn_mfma_f32_32x32x16_bf16(PAF(0),VFR(0),o[0],0,0,0), C0,0); \
    GAPB(o[1]=__builtin_amdgcn_mfma_f32_32x32x16_bf16(PAF(0),VFR(4),o[1],0,0,0), C0,4); \
    KRD(GL,0); GAPB(o[0]=__builtin_amdgcn_mfma_f32_32x32x16_bf16(PAF(1),VFR(1),o[0],0,0,0), C0,8); \
    KRD(GL,1); GAPB(o[1]=__builtin_amdgcn_mfma_f32_32x32x16_bf16(PAF(1),VFR(5),o[1],0,0,0), C0,12); \
    KRD(GL,2); GAPB(o[0]=__builtin_amdgcn_mfma_f32_32x32x16_bf16(PAF(2),VFR(2),o[0],0,0,0), C1,0); \
    KRD(GL,3); GAPB(o[1]=__builtin_amdgcn_mfma_f32_32x32x16_bf16(PAF(2),VFR(6),o[1],0,0,0), C1,4); \
    GAPB(o[0]=__builtin_amdgcn_mfma_f32_32x32x16_bf16(PAF(3),VFR(3),o[0],0,0,0), C1,8); \
    GAPB(o[1]=__builtin_amdgcn_mfma_f32_32x32x16_bf16(PAF(3),VFR(7),o[1],0,0,0), C1,12); \
    }while(0)
  int t=1;
  #undef CMASK
  #define CMASK(P0,P1,t) do{}while(0)
  for(;t+5<NT;t+=2){
    STEP(pB0,pB1,pA0,pA1,t,true,true,true);     WAIT_BAR(2); RESC(); ROT();
    STEP(pA0,pA1,pB0,pB1,t+1,true,true,true);   WAIT_BAR(2); RESC(); ROT();
  }
  #undef CMASK
  #define CMASK(P0,P1,t) do{}while(0)
  #define ENDW(tt) do{ if((tt)+3<NT){WAIT_BAR(2);} else if((tt)+2<NT){WAIT_BAR(1);} else {WAIT_BAR(0);} }while(0)
  for(;t+1<NT;t+=2){
    STEP(pB0,pB1,pA0,pA1,t,(t+3<NT),(t+1<NT),(t+1<NT));       ENDW(t);   RESC(); ROT();
    STEP(pA0,pA1,pB0,pB1,t+1,(t+4<NT),(t+2<NT),(t+2<NT));     ENDW(t+1); RESC(); ROT();
  }
  STEP(pB0,pB1,pA0,pA1,NT-1,false,false,false); RESC();
  { float sacc=pB0[0]+pB0[1]; _Pragma("unroll") for(int r=2;r<16;++r)sacc+=pB0[r]; _Pragma("unroll") for(int r=0;r<16;++r)sacc+=pB1[r]; l_reg+=sacc;
    pw0=(u32x4){PKW(pB0,0),PKW(pB0,2),PKW(pB0,4),PKW(pB0,6)};pw1=(u32x4){PKW(pB0,8),PKW(pB0,10),PKW(pB0,12),PKW(pB0,14)};pw2=(u32x4){PKW(pB1,0),PKW(pB1,2),PKW(pB1,4),PKW(pB1,6)};pw3=(u32x4){PKW(pB1,8),PKW(pB1,10),PKW(pB1,12),PKW(pB1,14)};
    SBAR(); pv(o,vb0+sl_cur,PAF(0),PAF(1),PAF(2),PAF(3)); }
  #undef PKW
  #undef PAF
  #undef VFR
  #undef PIN
  #undef MX3
  #undef GAPA
  #undef GAPB
  #undef EX
  #undef VRD
  #undef KRD
  #undef STEP
  #undef ENDW
  {auto rr=__builtin_amdgcn_permlane32_swap(__float_as_uint(l_reg),__float_as_uint(l_reg),false,false);l_reg=__uint_as_float(rr[0])+__uint_as_float(rr[1]);}
  if(hi==0)wsf[32+r32]=l_reg;asm volatile("s_waitcnt lgkmcnt(0)":::"memory");
  float rli[16];
  #pragma unroll
  for(int r=0;r<16;++r)rli[r]=__builtin_amdgcn_rcpf(wsf[32+crow(r,hi)]);
  bf16*Ow=J.O+(long)(wid*QBLK)*J.op;
  if(J.npass==1){ bf16*stg=(bf16*)(shm+LDS_OST)+wid*2048;
    #pragma unroll
    for(int r=0;r<16;++r){const int orow=crow(r,hi);
      #pragma unroll
      for(int d0=0;d0<2;++d0)stg[orow*64+d0*32+r32]=__float2bfloat16(o[d0][r]*rli[r]);}
    asm volatile("s_waitcnt lgkmcnt(0)":::"memory");
    #pragma unroll
    for(int i=0;i<4;++i){const int row=i*8+(lane>>3),ch=lane&7; const u32x4 v=*(const u32x4*)(stg+row*64+ch*8); *(u32x4*)(Ow+(long)row*J.op+ch*8)=v;} }
  else { float*st=(float*)(shm+LDS_STASH)+wid*2048;
    if(pass==0){
      #pragma unroll
      for(int r=0;r<16;++r){
        #pragma unroll
        for(int d0=0;d0<2;++d0)st[(r*2+d0)*64+lane]=o[d0][r]*rli[r];}
    } else {
      float dv[2][16];
      #pragma unroll
      for(int r=0;r<16;++r){
        #pragma unroll
        for(int d0=0;d0<2;++d0)dv[d0][r]=st[(r*2+d0)*64+lane]-J.lam*(o[d0][r]*rli[r]);}
      asm volatile("s_waitcnt lgkmcnt(0)":::"memory");
      #pragma unroll
      for(int r=0;r<16;++r){const int orow=crow(r,hi);
        #pragma unroll
        for(int d0=0;d0<2;++d0)st[orow*64+d0*32+r32]=dv[d0][r];}
      asm volatile("s_waitcnt lgkmcnt(0)":::"memory");
      #pragma unroll
      for(int i=0;i<4;++i){const int row=i*8+(lane>>3),ch=lane&7;
        const f32x4a a=*(const f32x4a*)(st+row*64+ch*8), b2=*(const f32x4a*)(st+row*64+ch*8+4);
        float ss=(a[0]*a[0]+a[1]*a[1])+(a[2]*a[2]+a[3]*a[3])+(b2[0]*b2[0]+b2[1]*b2[1])+(b2[2]*b2[2]+b2[3]*b2[3]);
        ss+=__shfl_xor(ss,1);ss+=__shfl_xor(ss,2);ss+=__shfl_xor(ss,4);
        const float rs=rsqrtf(ss*(1.0f/64.0f)+1e-6f)*J.oscale;
        const f32x4a g0=*(const f32x4a*)(J.gain+ch*8), g1=*(const f32x4a*)(J.gain+ch*8+4);
        u32x4 v; v[0]=cvtpk_s(a[0]*rs*g0[0],a[1]*rs*g0[1]); v[1]=cvtpk_s(a[2]*rs*g0[2],a[3]*rs*g0[3]); v[2]=cvtpk_s(b2[0]*rs*g1[0],b2[1]*rs*g1[1]); v[3]=cvtpk_s(b2[2]*rs*g1[2],b2[3]*rs*g1[3]);
        *(u32x4*)(Ow+(long)row*J.op+ch*8)=v;}
    } }
  asm volatile("s_waitcnt lgkmcnt(0)\n\ts_barrier":::"memory");
  #undef DMA_K
  #undef DMA_V
  #undef CMASK
  #undef START
  #undef RESC
  #undef ROT
 }
}
constexpr int ATTN_LDS_BYTES=LDS_BYTES;
#undef SBAR
#undef WAIT_BAR
}
#define LAS __attribute__((address_space(3)))
typedef unsigned short bfu;
typedef unsigned v4u __attribute__((ext_vector_type(4)));
typedef unsigned v2u __attribute__((ext_vector_type(2)));
typedef float f32x4 __attribute__((ext_vector_type(4)));
typedef short bf16x8 __attribute__((ext_vector_type(8)));
constexpr int NWAVES = 8, NTHR = 512;
constexpr int BATCH = 32, SEQ = 2048, DM = 1024, M = BATCH * SEQ, NIN = 3072, DFF = 4096, NMOD = 6144;
constexpr size_t MiB = 1u << 20;
constexpr size_t WS_CTL = 0, CTL_ZERO_BYTES = 8192;
constexpr size_t WS_MOD = 1 * MiB;
constexpr size_t WS_ROPE = 3 * MiB;
constexpr size_t WS_WIN = 4 * MiB, WS_WOUT = 16 * MiB, WS_WFF1 = 20 * MiB, WS_WFF2 = 36 * MiB;
constexpr size_t WS_HN = 64 * MiB;
constexpr size_t WS_MIX = 192 * MiB;
constexpr size_t WS_OF = 320 * MiB;
constexpr size_t WS_Z = 384 * MiB;
constexpr size_t WS_QA = 768 * MiB, WS_KA = 816 * MiB, WS_QB = 832 * MiB, WS_KB = 928 * MiB;
constexpr size_t WS_HID = 384 * MiB;
constexpr size_t WS_END = 976 * MiB;
constexpr int LDS_TOTAL = 149504;
static_assert(attn_body::ATTN_LDS_BYTES <= LDS_TOTAL && pg8::STAGE_BYTES <= LDS_TOTAL, "lds");

struct Params {
    const float *x, *c, *w_mod, *b_mod, *w_in, *a_qk_norm, *diff_lambda, *diff_subln, *hgrn_lb, *hgrn_norm, *w_out, *w_ff1, *w_ff2, *final_norm;
    float* out; unsigned char* ws;
};

__device__ __forceinline__ float bf2f(unsigned short u) { return __uint_as_float((unsigned)u << 16); }
__device__ __forceinline__ unsigned pkbf(float lo, float hi) { typedef float f2 __attribute__((ext_vector_type(2))); typedef __bf16 b2 __attribute__((ext_vector_type(2))); f2 v = {lo, hi}; b2 b = __builtin_convertvector(v, b2); return __builtin_bit_cast(unsigned, b); }
__device__ __forceinline__ unsigned short f2bf1(float x) { return (unsigned short)(pkbf(x, 0.f) & 0xffffu); }
__device__ __forceinline__ float wave_sum(float v) {
#pragma unroll
    for (int o = 1; o < 64; o <<= 1) v += __shfl_xor(v, o);
    return v;
}
__device__ __forceinline__ float sigmoidf_(float x) { return 1.0f / (1.0f + __expf(-x)); }

__device__ __forceinline__ void p0_transpose_item(const float* W, int K, int N, bfu* WT, LAS float* scr, int item, int lane) {
    const int nblk = N / 32, kb = item / nblk, nb = item % nblk, k0 = 64 * kb, n0 = 32 * nb;
#pragma unroll 8
    for (int i = 0; i < 32; ++i) { const int kk = 2 * i + (lane >> 5); scr[kk * 33 + (lane & 31)] = W[(size_t)(k0 + kk) * N + n0 + (lane & 31)]; }
    asm volatile("s_waitcnt lgkmcnt(0)" ::: "memory");
    const int c = lane & 7;
#pragma unroll
    for (int j = 0; j < 4; ++j) { const int n = (lane >> 3) + 8 * j; const LAS float* s = scr + (8 * c) * 33 + n;
        v4u o; o.x = pkbf(s[0 * 33], s[1 * 33]); o.y = pkbf(s[2 * 33], s[3 * 33]); o.z = pkbf(s[4 * 33], s[5 * 33]); o.w = pkbf(s[6 * 33], s[7 * 33]);
        *(v4u*)(WT + (size_t)(n0 + n) * K + k0 + 8 * c) = o; }
    asm volatile("s_waitcnt lgkmcnt(0)" ::: "memory");
}

__device__ __forceinline__ void phase_prologue(const Params& p, LAS unsigned char* lds, int tid, int lane, int wave) {
    const int G = gridDim.x;
    float* MOD = (float*)(p.ws + WS_MOD);
    LAS float* SC = (LAS float*)lds;
    for (int u = blockIdx.x; u < 2 * (NMOD / 64); u += G) {
        const int l = u / (NMOD / 64), cg0 = (u % (NMOD / 64)) * 64;
        for (int i = tid; i < BATCH * DM; i += NTHR) { const float cv = p.c[i]; SC[i] = cv * sigmoidf_(cv); }
        __syncthreads();
        float acc[32];
#pragma unroll
        for (int b = 0; b < 32; ++b) acc[b] = 0.f;
        const float* wp = p.w_mod + ((size_t)l * DM + wave * 128) * NMOD + cg0 + lane;
        for (int k4 = 0; k4 < 128; k4 += 4) {
            const float w0 = wp[(size_t)(k4 + 0) * NMOD], w1 = wp[(size_t)(k4 + 1) * NMOD], w2 = wp[(size_t)(k4 + 2) * NMOD], w3 = wp[(size_t)(k4 + 3) * NMOD];
#pragma unroll
            for (int b = 0; b < 32; ++b) { const f32x4 s = *(const LAS f32x4*)(SC + b * DM + wave * 128 + k4); acc[b] += s[0] * w0 + s[1] * w1 + s[2] * w2 + s[3] * w3; }
        }
        __syncthreads();
        LAS float* RED = (LAS float*)lds;
#pragma unroll
        for (int b = 0; b < 32; ++b) RED[(wave * 32 + b) * 64 + lane] = acc[b];
        __syncthreads();
#pragma unroll
        for (int bb = 0; bb < 4; ++bb) { const int b = wave * 4 + bb; float s = 0.f;
#pragma unroll
            for (int w = 0; w < 8; ++w) s += RED[(w * 32 + b) * 64 + lane];
            MOD[((size_t)l * BATCH + b) * NMOD + cg0 + lane] = s + p.b_mod[l * NMOD + cg0 + lane]; }
        __syncthreads();
    }
    {
        float* ROPE = (float*)(p.ws + WS_ROPE);
        for (int i = blockIdx.x * NTHR + tid; i < 2048 * 16; i += G * NTHR) {
            const int pos = i >> 4, j = i & 15;
            const double inv = exp2(-(double)j * (13.287712379549449 / 16.0));
            const double rev = (double)pos * inv * 0.15915494309189535;
            const float fr = (float)(rev - floor(rev));
            ROPE[2 * i] = __builtin_amdgcn_cosf(fr); ROPE[2 * i + 1] = __builtin_amdgcn_sinf(fr);
        }
    }
    {
        LAS float* scr = (LAS float*)(lds + wave * 16384);
        const int gw = blockIdx.x * NWAVES + wave, NGW = G * NWAVES;
        constexpr int I_IN = (DM / 64) * (NIN / 32), I_OUT = (DM / 64) * (DM / 32), I_F1 = (DM / 64) * (DFF / 32), I_F2 = (DFF / 64) * (DM / 32);
        constexpr int PER_L = I_IN + I_OUT + I_F1 + I_F2;
        for (int it = gw; it < 2 * PER_L; it += NGW) {
            const int l = it / PER_L; int r = it % PER_L;
            if (r < I_IN) { p0_transpose_item(p.w_in + (size_t)l * DM * NIN, DM, NIN, (bfu*)(p.ws + WS_WIN) + (size_t)l * NIN * DM, scr, r, lane); continue; } r -= I_IN;
            if (r < I_OUT) { p0_transpose_item(p.w_out + (size_t)l * DM * DM, DM, DM, (bfu*)(p.ws + WS_WOUT) + (size_t)l * DM * DM, scr, r, lane); continue; } r -= I_OUT;
            if (r < I_F1) { p0_transpose_item(p.w_ff1 + (size_t)l * DM * DFF, DM, DFF, (bfu*)(p.ws + WS_WFF1) + (size_t)l * DFF * DM, scr, r, lane); continue; } r -= I_F1;
            p0_transpose_item(p.w_ff2 + (size_t)l * DFF * DM, DFF, DM, (bfu*)(p.ws + WS_WFF2) + (size_t)l * DM * DFF, scr, r, lane);
        }
    }
}

__device__ __forceinline__ void phase_modnorm(const float* xin, const float* modl  , int off_sh, int off_sc, bfu* HN, int lane, int wave) {
    const int gw = blockIdx.x * NWAVES + wave, NGW = gridDim.x * NWAVES;
    for (int m = gw; m < M; m += NGW) {
        const f32x4* xr = (const f32x4*)(xin + (size_t)m * DM) + lane;
        const float* mb = modl + (size_t)(m >> 11) * NMOD;
        f32x4 v[4]; float s = 0.f;
#pragma unroll
        for (int j = 0; j < 4; ++j) { v[j] = xr[64 * j]; s += (v[j][0] * v[j][0] + v[j][1] * v[j][1]) + (v[j][2] * v[j][2] + v[j][3] * v[j][3]); }
        const float rs = rsqrtf(wave_sum(s) * (1.f / DM) + 1e-6f);
        unsigned long long* o8 = (unsigned long long*)(HN + (size_t)m * DM) + lane;
#pragma unroll
        for (int j = 0; j < 4; ++j) { const f32x4 sc = *((const f32x4*)(mb + off_sc) + lane + 64 * j), sh = *((const f32x4*)(mb + off_sh) + lane + 64 * j);
            const f32x4 y = v[j] * rs * (sc + 1.0f) + sh;
            o8[64 * j] = (unsigned long long)pkbf(y[0], y[1]) | ((unsigned long long)pkbf(y[2], y[3]) << 32); }
    }
}
__device__ __forceinline__ void phase_finalnorm(float* x, const float* gain, int lane, int wave) {
    const int gw = blockIdx.x * NWAVES + wave, NGW = gridDim.x * NWAVES;
    for (int m = gw; m < M; m += NGW) {
        f32x4* xr = (f32x4*)(x + (size_t)m * DM) + lane;
        f32x4 v[4]; float s = 0.f;
#pragma unroll
        for (int j = 0; j < 4; ++j) { v[j] = xr[64 * j]; s += (v[j][0] * v[j][0] + v[j][1] * v[j][1]) + (v[j][2] * v[j][2] + v[j][3] * v[j][3]); }
        const float rs = rsqrtf(wave_sum(s) * (1.f / DM) + 1e-6f);
#pragma unroll
        for (int j = 0; j < 4; ++j) { const f32x4 g = *((const f32x4*)gain + lane + 64 * j); xr[64 * j] = v[j] * rs * g; }
    }
}

__device__ __forceinline__ void unpack8(const v4u r, float (&v)[8]) {
#pragma unroll
    for (int i = 0; i < 4; ++i) { v[2 * i] = __uint_as_float(r[i] << 16); v[2 * i + 1] = __uint_as_float(r[i] & 0xffff0000u); }
}
__device__ __forceinline__ v4u pack8(const float (&v)[8]) { v4u o; o[0] = pkbf(v[0], v[1]); o[1] = pkbf(v[2], v[3]); o[2] = pkbf(v[4], v[5]); o[3] = pkbf(v[6], v[7]); return o; }
__device__ __forceinline__ void rope8(float (&v)[8], const float* tab, bool second) {
    float pv[8];
#pragma unroll
    for (int k = 0; k < 8; ++k) pv[k] = __shfl_xor(v[k], 2);
#pragma unroll
    for (int k4 = 0; k4 < 4; ++k4) { const f32x4 cs = *(const f32x4*)(tab + 4 * k4);
        const int k = 2 * k4;
        v[k] = second ? v[k] * cs[0] + pv[k] * cs[1] : v[k] * cs[0] - pv[k] * cs[1];
        v[k + 1] = second ? v[k + 1] * cs[2] + pv[k + 1] * cs[3] : v[k + 1] * cs[2] - pv[k + 1] * cs[3]; }
}
__device__ __forceinline__ void phase_post(const Params& p, int l, int lane, int wave) {
    const bfu* Z = (const bfu*)(p.ws + WS_Z); const float* ROPE = (const float*)(p.ws + WS_ROPE);
    bfu* QA = (bfu*)(p.ws + WS_QA); bfu* KA = (bfu*)(p.ws + WS_KA); bfu* QB = (bfu*)(p.ws + WS_QB); bfu* KB = (bfu*)(p.ws + WS_KB);
    const float C2A = 0.125f * attn_body::LOG2E, C2B = 0.17677669529663687f * attn_body::LOG2E;
    const int gw = blockIdx.x * NWAVES + wave, NGW = gridDim.x * NWAVES;
    for (int m = gw; m < M; m += NGW) {
        const int s = m & 2047, prow = s >> 6, pcol = s & 63;
        const bfu* zr = Z + (size_t)m * NIN;
        {
            const int head = lane >> 3, ch = lane & 7;
            float v[8]; unpack8(*(const v4u*)(zr + head * 64 + ch * 8), v);
            float ss = 0.f;
#pragma unroll
            for (int k = 0; k < 8; ++k) ss += v[k] * v[k];
            ss += __shfl_xor(ss, 1); ss += __shfl_xor(ss, 2); ss += __shfl_xor(ss, 4);
            const float rs = rsqrtf(ss * (1.f / 64.f) + 1e-6f);
            const float* gp = p.a_qk_norm + l * 128 + (head < 6 ? 0 : 64) + ch * 8;
            const f32x4 g0 = *(const f32x4*)gp, g1 = *(const f32x4*)(gp + 4);
#pragma unroll
            for (int k = 0; k < 4; ++k) { v[k] *= rs * g0[k]; v[k + 4] *= rs * g1[k]; }
            const int pos = (ch & 4) ? pcol : prow;
            rope8(v, ROPE + (pos * 16 + 8 * (ch & 1)) * 2, (ch & 2) != 0);
            if (head < 6) {
#pragma unroll
                for (int k = 0; k < 8; ++k) v[k] *= C2A;
                *(v4u*)(QA + (size_t)m * 384 + head * 64 + ch * 8) = pack8(v);
            } else *(v4u*)(KA + (size_t)m * 128 + (head - 6) * 64 + ch * 8) = pack8(v);
        }
        {
            const bool act = lane < 48; const int ln = act ? lane : lane - 48;
            const int hc = ln >> 2, ch = ln & 3;
            const float* tab = ROPE + (s * 16 + 8 * (ch & 1)) * 2;
            float v[8]; unpack8(*(const v4u*)(zr + 640 + hc * 32 + ch * 8), v);
            rope8(v, tab, (ch & 2) != 0);
#pragma unroll
            for (int k = 0; k < 8; ++k) v[k] *= C2B;
            if (act) { const int comp = hc & 1; bfu* qd = QB + (size_t)m * 768 + hc * 64;
                *(v4u*)(qd + comp * 32 + ch * 8) = pack8(v); *(v4u*)(qd + (1 - comp) * 32 + ch * 8) = (v4u){0u, 0u, 0u, 0u}; }
            unpack8(*(const v4u*)(zr + 1024 + hc * 32 + ch * 8), v);
            rope8(v, tab, (ch & 2) != 0);
            if (act) *(v4u*)(KB + (size_t)m * 384 + hc * 32 + ch * 8) = pack8(v);
        }
    }
}
namespace hg {
constexpr int PB = 144;
constexpr int QE = 0, QC = 9216, KV = 18432, KLT = 55296, VT = 64512, ST = 73728, PP = 82944, TOT = 92160, AA = 94208, OO = 94464, LDS_BYTES = OO + 64 * 68 * 4;
static_assert(LDS_BYTES <= LDS_TOTAL, "hgrn lds");
#define HG_MFMA(a, b, c) __builtin_amdgcn_mfma_f32_16x16x32_bf16(a, b, c, 0, 0, 0)
#define HG_LD8(off) (*(const LAS bf16x8*)(L + (off)))
__device__ __forceinline__ void hgrn_scan(LAS unsigned char* L, const Params& p, int layer, int b, int h, int dir) {
    int tid_ = threadIdx.x; asm volatile("" : "+v"(tid_));
    const int tid = tid_, lane = tid & 63, g = __builtin_amdgcn_readfirstlane(tid >> 6), fr = lane & 15, fq = lane >> 4;
    const bfu* Z = (const bfu*)(p.ws + WS_Z); float* OF = (float*)(p.ws + (dir ? WS_HN : WS_OF));
    const int d = lane;
    float lb = 0.f;
    if (layer == 1) { const float b0 = p.hgrn_lb[h * 64 + d], b1 = p.hgrn_lb[256 + h * 64 + d]; lb = fminf(fmaxf(1.0f / (1.0f + __expf(b0 - b1)), 0.f), 1.f); }
    const float oml = 1.0f - lb;
    const int I = g >> 1, jh = g & 1;
    for (int i = tid; i < 64 * PB / 4; i += NTHR) ((LAS unsigned*)(L + ST))[i] = 0u;
    f32x4 Sreg[2]; Sreg[0] = (f32x4){0.f, 0.f, 0.f, 0.f}; Sreg[1] = Sreg[0];
    const int qcol = 1792 + h * 64 + d, fcol = (dir ? 2304 : 2048) + h * 64 + d, vcol = 2560 + h * 64 + d;
    const long rstep = dir ? -(long)NIN : (long)NIN;
    const bfu* zrow = Z + ((size_t)b * SEQ + (dir ? 2047 - 8 * g : 8 * g)) * NIN;
    unsigned short rq[8], rf[8], rv[8];
#pragma unroll
    for (int j = 0; j < 8; ++j) { const bfu* zr = zrow + rstep * j; rq[j] = zr[qcol]; rf[j] = zr[fcol]; rv[j] = zr[vcol]; }
    for (int c = 0; c < 32; ++c) {
        float bl[8], qv[8], kk[8]; unsigned short vb[8]; float run = 0.f;
#pragma unroll
        for (int j = 0; j < 8; ++j) {
            const float zq = bf2f(rq[j]); float zf = bf2f(rf[j]); vb[j] = rv[j];
            zf = fminf(fmaxf(zf, -30.f), 30.f);
            const float e = __expf(-zf), sig = __builtin_amdgcn_rcpf(1.0f + e);
            const float f = lb + oml * sig;
            run += __logf(fmaxf(f, 1e-6f)); bl[j] = run; kk[j] = oml * e * sig;
            qv[j] = zq * __builtin_amdgcn_rcpf(1.0f + __expf(-zq)) * 0.125f;
        }
        ((LAS float*)(L + TOT))[g * 64 + d] = run;
        if (c < 31) {
            const bfu* zn = zrow + rstep * 64 * (c + 1);
#pragma unroll
            for (int j = 0; j < 8; ++j) { const bfu* zr = zn + rstep * j; rq[j] = zr[qcol]; rf[j] = zr[fcol]; rv[j] = zr[vcol]; }
        }
        __syncthreads();
        float R1 = 0.f, R2 = 0.f, R3 = 0.f, blast, sub = 0.f;
        { float pp = 0.f;
#pragma unroll
          for (int g2 = 0; g2 < 8; ++g2) { const float tv = ((const LAS float*)(L + TOT))[g2 * 64 + d]; if (g2 == 2) R1 = pp; if (g2 == 4) R2 = pp; if (g2 == 6) R3 = pp; if (g2 + 1 == g && jh == 1) sub = tv; pp += tv; }
          blast = pp; }
        const float RI = I == 0 ? 0.f : (I == 1 ? R1 : (I == 2 ? R2 : R3));
        const float EI = __expf(RI), F1 = __expf(R1 - RI), F2 = __expf(R2 - RI), F3 = __expf(R3 - RI), GL = __expf(blast - RI);
#pragma unroll
        for (int j = 0; j < 8; ++j) {
            const int t = 8 * g + j; const float lc = sub + bl[j];
            const float qe = qv[j] * __expf(lc), kb = kk[j] * __expf(fminf(-lc, 80.f));
            *(LAS unsigned short*)(L + QE + t * PB + d * 2) = f2bf1(qe);
            *(LAS unsigned short*)(L + QC + t * PB + d * 2) = f2bf1(qe * EI);
            if (I == 0) *(LAS unsigned short*)(L + KV + 0 * 9216 + t * PB + d * 2) = f2bf1(kb);
            if (I <= 1) *(LAS unsigned short*)(L + KV + 1 * 9216 + t * PB + d * 2) = f2bf1(I == 1 ? kb : kb * F1);
            if (I <= 2) *(LAS unsigned short*)(L + KV + 2 * 9216 + t * PB + d * 2) = f2bf1(I == 2 ? kb : kb * F2);
            *(LAS unsigned short*)(L + KV + 3 * 9216 + t * PB + d * 2) = f2bf1(I == 3 ? kb : kb * F3);
            bl[j] = kb * GL;
        }
        { unsigned klp[4], vp[4];
#pragma unroll
          for (int j = 0; j < 4; ++j) { klp[j] = pkbf(bl[2 * j], bl[2 * j + 1]); vp[j] = (unsigned)vb[2 * j] | ((unsigned)vb[2 * j + 1] << 16); }
          *(LAS v4u*)(L + KLT + d * PB + g * 16) = (v4u){klp[0], klp[1], klp[2], klp[3]};
          *(LAS v4u*)(L + VT + d * PB + g * 16) = (v4u){vp[0], vp[1], vp[2], vp[3]}; }
        if (g == 0) ((LAS float*)(L + AA))[d] = __expf(blast);
        __syncthreads();
#pragma unroll
        for (int jj = 0; jj < 2; ++jj) { const int Jb = 2 * jh + jj;
            f32x4 acc = (f32x4){0.f, 0.f, 0.f, 0.f};
            if (Jb <= I) {
#pragma unroll
                for (int k2 = 0; k2 < 2; ++k2) acc = HG_MFMA(HG_LD8(QE + (16 * I + fr) * PB + (k2 * 32 + 8 * fq) * 2), HG_LD8(KV + I * 9216 + (16 * Jb + fr) * PB + (k2 * 32 + 8 * fq) * 2), acc);
            }
#pragma unroll
            for (int i = 0; i < 4; ++i) { const float val = (Jb < I || (Jb == I && fr <= 4 * fq + i)) ? acc[i] : 0.f;
                *(LAS unsigned short*)(L + PP + (16 * I + 4 * fq + i) * PB + (16 * Jb + fr) * 2) = f2bf1(val); }
        }
        __syncthreads();
        const f32x4 a4 = *(const LAS f32x4*)(L + AA + (16 * I + 4 * fq) * 4);
#pragma unroll
        for (int nn = 0; nn < 2; ++nn) { const int n = 2 * jh + nn;
            f32x4 acc = (f32x4){0.f, 0.f, 0.f, 0.f};
#pragma unroll
            for (int k2 = 0; k2 < 2; ++k2) acc = HG_MFMA(HG_LD8(PP + (16 * I + fr) * PB + (k2 * 32 + 8 * fq) * 2), HG_LD8(VT + (16 * n + fr) * PB + (k2 * 32 + 8 * fq) * 2), acc);
#pragma unroll
            for (int k2 = 0; k2 < 2; ++k2) acc = HG_MFMA(HG_LD8(QC + (16 * I + fr) * PB + (k2 * 32 + 8 * fq) * 2), HG_LD8(ST + (16 * n + fr) * PB + (k2 * 32 + 8 * fq) * 2), acc);
#pragma unroll
            for (int i = 0; i < 4; ++i) ((LAS float*)(L + OO))[(16 * I + 4 * fq + i) * 68 + 16 * n + fr] = acc[i];
            f32x4 sr = Sreg[nn] * a4;
#pragma unroll
            for (int k2 = 0; k2 < 2; ++k2) sr = HG_MFMA(HG_LD8(KLT + (16 * I + fr) * PB + (k2 * 32 + 8 * fq) * 2), HG_LD8(VT + (16 * n + fr) * PB + (k2 * 32 + 8 * fq) * 2), sr);
            Sreg[nn] = sr;
        }
        __syncthreads();
#pragma unroll
        for (int nn = 0; nn < 2; ++nn) { const int n = 2 * jh + nn;
            *(LAS v2u*)(L + ST + (16 * n + fr) * PB + (16 * I + 4 * fq) * 2) = (v2u){pkbf(Sreg[nn][0], Sreg[nn][1]), pkbf(Sreg[nn][2], Sreg[nn][3])}; }
        {
            const int t = tid >> 3, j8 = tid & 7;
            const f32x4 o0 = *(const LAS f32x4*)(L + OO + (t * 68 + 8 * j8) * 4), o1 = *(const LAS f32x4*)(L + OO + (t * 68 + 8 * j8 + 4) * 4);
            const size_t row = (size_t)b * SEQ + (dir ? 2047 - (64 * c + t) : 64 * c + t);
            float* ofp = OF + row * 256 + h * 64 + 8 * j8;
            *(f32x4*)ofp = o0; *(f32x4*)(ofp + 4) = o1;
        }
    }
    __threadfence();
    __syncthreads();
}
__device__ __forceinline__ void hgrn_combine(const Params& p, int layer, int it) {
    int tid = threadIdx.x; asm volatile("" : "+v"(tid));
    const bfu* Z = (const bfu*)(p.ws + WS_Z); const float* OFf = (const float*)(p.ws + WS_OF); const float* OFb = (const float*)(p.ws + WS_HN); bfu* MIX = (bfu*)(p.ws + WS_MIX);
    const float* gain = p.hgrn_norm + layer * 64;
#pragma unroll 2
    for (int k = 0; k < 16; ++k) {
        const int idx = tid + NTHR * k, r = idx >> 5, cgp = idx & 31; const size_t row = (size_t)it * 256 + r; const int col = 8 * cgp;
        const unsigned long long* pf = (const unsigned long long*)(OFf + row * 256 + col); const unsigned long long* pb = (const unsigned long long*)(OFb + row * 256 + col);
        float sv[8];
#pragma unroll
        for (int q = 0; q < 4; ++q) { const unsigned long long wf = __hip_atomic_load(pf + q, __ATOMIC_RELAXED, __HIP_MEMORY_SCOPE_AGENT), wb = __hip_atomic_load(pb + q, __ATOMIC_RELAXED, __HIP_MEMORY_SCOPE_AGENT);
            sv[2 * q] = __uint_as_float((unsigned)wf) + __uint_as_float((unsigned)wb); sv[2 * q + 1] = __uint_as_float((unsigned)(wf >> 32)) + __uint_as_float((unsigned)(wb >> 32)); }
        float ss = 0.f;
#pragma unroll
        for (int q = 0; q < 8; ++q) ss += sv[q] * sv[q];
        ss += __shfl_xor(ss, 1); ss += __shfl_xor(ss, 2); ss += __shfl_xor(ss, 4);
        const float rs = rsqrtf(ss * (1.f / 64.f) + 1e-6f);
        float zg[8]; unpack8(*(const v4u*)(Z + row * NIN + 2816 + col), zg);
        const f32x4 g0 = *(const f32x4*)(gain + (col & 63)), g1 = *(const f32x4*)(gain + (col & 63) + 4);
#pragma unroll
        for (int q = 0; q < 4; ++q) { sv[q] = sv[q] * rs * g0[q] * (zg[q] * sigmoidf_(zg[q])); sv[q + 4] = sv[q + 4] * rs * g1[q] * (zg[q + 4] * sigmoidf_(zg[q + 4])); }
        *(v4u*)(MIX + row * DM + 768 + col) = pack8(sv);
    }
}
#undef HG_MFMA
#undef HG_LD8
}
__device__ __forceinline__ void phase_mixer(const Params& p, int l, LAS unsigned char* lds, unsigned* ctr) {
    using attn_body::bf16;
    int tid = threadIdx.x; asm volatile("" : "+v"(tid));
    const bf16* Z = (const bf16*)(p.ws + WS_Z); bf16* MIX = (bf16*)(p.ws + WS_MIX);
    const bf16* QA = (const bf16*)(p.ws + WS_QA); const bf16* KA = (const bf16*)(p.ws + WS_KA); const bf16* QB = (const bf16*)(p.ws + WS_QB); const bf16* KB = (const bf16*)(p.ws + WS_KB);
    float lam;
    { const float* lp = p.diff_lambda + l * 128; float s1 = 0.f, s2 = 0.f;
      for (int i = 0; i < 32; ++i) { s1 += lp[i] * lp[32 + i]; s2 += lp[64 + i] * lp[96 + i]; }
      const float lam_init = (l == 0) ? 0.2f : (0.8f - 0.6f * 0.7408182206817179f);
      lam = expf(s1) - expf(s2) + lam_init; }
    const float lam_init = (l == 0) ? 0.2f : (0.8f - 0.6f * 0.7408182206817179f);
    constexpr int Q_H = 32, Q_B = 192, Q_A = 192, Q_C = 32, PER_Q = Q_H + Q_B + Q_A + Q_C;
    LAS int* nxt = (LAS int*)(lds + LDS_TOTAL - 16);
    unsigned* hdone = ctr + 16;
    const int xcd = (int)(blockIdx.x & 7u);
    const int q = xcd;
    int i = (int)(blockIdx.x >> 3);
    const int first_dyn = (int)(gridDim.x >> 3);
    while (i < PER_Q) {
        if (i < Q_H) { const int s = i * 8 + q;
            hg::hgrn_scan(lds, p, l, s >> 3, (s >> 1) & 3, s & 1);
            if (tid == 0) __hip_atomic_fetch_add(hdone, 1u, __ATOMIC_RELEASE, __HIP_MEMORY_SCOPE_AGENT);
        } else if (i >= Q_H + Q_B + Q_A) {
            if (tid == 0) { unsigned sp = 0; while (__hip_atomic_load(hdone, __ATOMIC_RELAXED, __HIP_MEMORY_SCOPE_AGENT) < 256u && ++sp < (1u << 24)) __builtin_amdgcn_s_sleep(8);
                __builtin_amdgcn_fence(__ATOMIC_ACQUIRE, "agent"); }
            __syncthreads();
            hg::hgrn_combine(p, l, (i - (Q_H + Q_B + Q_A)) * 8 + q);
        } else {
            attn_body::AttnJob J;
            if (i < Q_H + Q_B) { const int u = i - Q_H, grp = (u >> 3) * 8 + q, b = grp / 6, h = grp % 6, qb = u & 7; const size_t r0 = (size_t)b * SEQ, rq = r0 + qb * 256;
                J.Q = QB + rq * 768 + h * 128; J.qp = 768; J.K = KB + r0 * 384 + h * 64; J.kp = 384; J.V = Z + r0 * NIN + 1408 + h * 64; J.vp = NIN;
                J.O = MIX + rq * DM + 384 + h * 64; J.op = DM; J.npass = 2; J.lam = lam; J.gain = p.diff_subln + l * 64; J.oscale = 1.0f - lam_init; }
            else { const int u = i - Q_H - Q_B, grp = (u / 24) * 8 + q, b = grp >> 1, kvh = grp & 1, r = u % 24, gq = r >> 3, qb = r & 7, head = kvh * 3 + gq; const size_t r0 = (size_t)b * SEQ, rq = r0 + qb * 256;
                J.Q = QA + rq * 384 + head * 64; J.qp = 384; J.K = KA + r0 * 128 + kvh * 64; J.kp = 128; J.V = Z + r0 * NIN + 512 + kvh * 64; J.vp = NIN;
                J.O = MIX + rq * DM + head * 64; J.op = DM; J.npass = 1; J.lam = 0.f; J.gain = p.diff_subln; J.oscale = 1.f; }
            attn_body::attn_unit<8>(J, (char*)lds);
        }
        if (tid == 0) *nxt = (int)atomicAdd(ctr + 64 * q, 1u) + first_dyn;
        __syncthreads();
        i = *nxt;
        __syncthreads();
    }
}

typedef const __attribute__((address_space(4))) Params* KParams;
__device__ __forceinline__ Params ldp() {
#if defined(__HIP_DEVICE_COMPILE__)
    KParams k = (KParams)__builtin_amdgcn_kernarg_segment_ptr(); asm volatile("" : "+s"(k)); Params r;
    r.x = k->x; r.c = k->c; r.w_mod = k->w_mod; r.b_mod = k->b_mod; r.w_in = k->w_in; r.a_qk_norm = k->a_qk_norm; r.diff_lambda = k->diff_lambda; r.diff_subln = k->diff_subln; r.hgrn_lb = k->hgrn_lb;
    r.hgrn_norm = k->hgrn_norm; r.w_out = k->w_out; r.w_ff1 = k->w_ff1; r.w_ff2 = k->w_ff2; r.final_norm = k->final_norm; r.out = k->out; r.ws = k->ws; return r;
#else
    return Params{};
#endif
}
__global__ void __launch_bounds__(NTHR, 2) fwd_megakernel(Params p_unused) {
    extern __shared__ __attribute__((aligned(16))) unsigned char lds_raw[];
    LAS unsigned char* lds = (LAS unsigned char*)lds_raw;
    cg::grid_group grid = cg::this_grid();
    { int tid = threadIdx.x; asm volatile("" : "+v"(tid)); const int lane = tid & 63, wave = __builtin_amdgcn_readfirstlane(tid >> 6);
      const Params p = ldp(); phase_prologue(p, lds, tid, lane, wave); }
    grid.sync();
#pragma unroll 1
    for (int l = 0; l < 2; ++l) {
        { int tid = threadIdx.x; asm volatile("" : "+v"(tid)); const int lane = tid & 63, wave = __builtin_amdgcn_readfirstlane(tid >> 6);
          const Params p = ldp(); phase_modnorm((l == 0) ? p.x : p.out, (const float*)(p.ws + WS_MOD) + (size_t)l * BATCH * NMOD, 0, 1024, (bfu*)(p.ws + WS_HN), lane, wave); }
        grid.sync();
        {
            const Params p = ldp();
            pg8::Gemm g{(const bfu*)(p.ws + WS_HN), (const bfu*)(p.ws + WS_WIN) + (size_t)l * NIN * DM, M, NIN, DM}; pg8::StaticOrder S; S.init(M, NIN, (int)gridDim.x, (int)blockIdx.x);
            pg8::EpiBf16<0> E{(bfu*)(p.ws + WS_Z), NIN};
            pg8::gemm_phase<pg8::EpiBf16<0>, pg8::StaticOrder, PG8_ALIGN, PG8_SP2>(lds, g, S, E);
        }
        grid.sync();
        { int tid = threadIdx.x; asm volatile("" : "+v"(tid)); const int lane = tid & 63, wave = __builtin_amdgcn_readfirstlane(tid >> 6);
          const Params p = ldp(); phase_post(p, l, lane, wave); }
        grid.sync();
        { const Params p = ldp(); phase_mixer(p, l, lds, (unsigned*)(p.ws + WS_CTL) + 1024 * l); }
        grid.sync();
        {
            const Params p = ldp();
            pg8::Gemm g{(const bfu*)(p.ws + WS_MIX), (const bfu*)(p.ws + WS_WOUT) + (size_t)l * DM * DM, M, DM, DM}; pg8::StaticOrder S; S.init(M, DM, (int)gridDim.x, (int)blockIdx.x);
            pg8::EpiResGate E{(l == 0) ? p.x : p.out, p.out, (const float*)(p.ws + WS_MOD) + (size_t)l * BATCH * NMOD + 2048};
            pg8::gemm_phase<pg8::EpiResGate, pg8::StaticOrder, PG8_ALIGN, PG8_SP2>(lds, g, S, E);
        }
        grid.sync();
        { int tid = threadIdx.x; asm volatile("" : "+v"(tid)); const int lane = tid & 63, wave = __builtin_amdgcn_readfirstlane(tid >> 6);
          const Params p = ldp(); phase_modnorm(p.out, (const float*)(p.ws + WS_MOD) + (size_t)l * BATCH * NMOD, 3072, 4096, (bfu*)(p.ws + WS_HN), lane, wave); }
        grid.sync();
        {
            const Params p = ldp();
            pg8::Gemm g{(const bfu*)(p.ws + WS_HN), (const bfu*)(p.ws + WS_WFF1) + (size_t)l * DFF * DM, M, DFF, DM}; pg8::StaticOrder S; S.init(M, DFF, (int)gridDim.x, (int)blockIdx.x);
            pg8::EpiBf16<2> E{(bfu*)(p.ws + WS_HID), DFF};
            pg8::gemm_phase<pg8::EpiBf16<2>, pg8::StaticOrder, PG8_ALIGN, PG8_SP2>(lds, g, S, E);
        }
        grid.sync();
        {
            const Params p = ldp();
            pg8::Gemm g{(const bfu*)(p.ws + WS_HID), (const bfu*)(p.ws + WS_WFF2) + (size_t)l * DM * DFF, M, DM, DFF}; pg8::StaticOrder S; S.init(M, DM, (int)gridDim.x, (int)blockIdx.x);
            pg8::EpiResGate E{p.out, p.out, (const float*)(p.ws + WS_MOD) + (size_t)l * BATCH * NMOD + 5120};
            pg8::gemm_phase<pg8::EpiResGate, pg8::StaticOrder, PG8_ALIGN, PG8_SP2>(lds, g, S, E);
        }
        grid.sync();
    }
    { int tid = threadIdx.x; asm volatile("" : "+v"(tid)); const int lane = tid & 63, wave = __builtin_amdgcn_readfirstlane(tid >> 6);
      const Params p = ldp(); phase_finalnorm(p.out, p.final_norm, lane, wave); }
}

extern "C" void kernel_launch(void* const* d_in, const int* in_sizes, int n_in, void* d_out, int out_size, void* d_ws, size_t ws_size, hipStream_t stream) {
    static int grid = 0;
    if (grid == 0) {
        if (n_in != 14 || in_sizes[0] != M * DM || out_size != M * DM || ws_size < WS_END) { fprintf(stderr, "kernel_launch: unexpected shapes (n_in %d in0 %d out %d ws %zu)\n", n_in, n_in > 0 ? in_sizes[0] : -1, out_size, ws_size); grid = -1; return; }
        int dev = 0, cus = 0, per_cu = 0;
        hipGetDevice(&dev); hipDeviceGetAttribute(&cus, hipDeviceAttributeMultiprocessorCount, dev);
        if (hipFuncSetAttribute((const void*)fwd_megakernel, hipFuncAttributeMaxDynamicSharedMemorySize, LDS_TOTAL) != hipSuccess) { fprintf(stderr, "kernel_launch: hipFuncSetAttribute failed\n"); grid = -1; return; }
        if (hipOccupancyMaxActiveBlocksPerMultiprocessor(&per_cu, (const void*)fwd_megakernel, NTHR, LDS_TOTAL) != hipSuccess || per_cu < 1) { fprintf(stderr, "kernel_launch: occupancy query says %d\n", per_cu); per_cu = 1; }
        (void)hipGetLastError();
        grid = cus * 1;
        (void)per_cu;
    }
    if (grid < 0) return;
    hipMemsetAsync((char*)d_ws + WS_CTL, 0, CTL_ZERO_BYTES, stream);
    Params p{};
    p.x = (const float*)d_in[0]; p.c = (const float*)d_in[1]; p.w_mod = (const float*)d_in[2]; p.b_mod = (const float*)d_in[3]; p.w_in = (const float*)d_in[4];
    p.a_qk_norm = (const float*)d_in[5]; p.diff_lambda = (const float*)d_in[6]; p.diff_subln = (const float*)d_in[7]; p.hgrn_lb = (const float*)d_in[8]; p.hgrn_norm = (const float*)d_in[9];
    p.w_out = (const float*)d_in[10]; p.w_ff1 = (const float*)d_in[11]; p.w_ff2 = (const float*)d_in[12]; p.final_norm = (const float*)d_in[13];
    p.out = (float*)d_out; p.ws = (unsigned char*)d_ws;
    void* args[] = {&p};
    hipError_t e = hipLaunchCooperativeKernel((const void*)fwd_megakernel, dim3(grid), dim3(NTHR), args, LDS_TOTAL, stream);
    if (e != hipSuccess) fprintf(stderr, "cooperative launch failed: %s (grid %d)\n", hipGetErrorString(e), grid);
}
```

```cpp
#include <hip/hip_runtime.h>
#include <hip/hip_cooperative_groups.h>
#include <hip/hip_bf16.h>
#include <cstdio>
#include <cstdint>
#include <cmath>
namespace cg = cooperative_groups;
namespace pg8 {
#define PG8_LAS __attribute__((address_space(3)))
typedef unsigned short bf16_t;
typedef short bf16x8 __attribute__((ext_vector_type(8)));
typedef float f32x4 __attribute__((ext_vector_type(4)));
typedef unsigned u32x4 __attribute__((ext_vector_type(4)));
constexpr int BM = 256, BK = 64, HALF = 128, HTB = HALF * BK * 2  , STAGE_BYTES = 8 * HTB, NXCD = 8, WGM = 8;

__host__ __device__ __forceinline__ int lds_byte(int r, int c) { const int st = (r >> 4) * 2 + (c >> 5), rr = r & 15, cc = c & 31, ob = rr * 64 + cc * 2; return st * 1024 + (ob ^ (((ob >> 9) & 1) << 5)); }
__host__ __device__ __forceinline__ void stage_rc(int b, int& R, int& C) { const int st = b / 1024, sb = b % 1024, swz = sb ^ (((sb >> 9) & 1) << 5); R = (st >> 1) * 16 + swz / 64; C = (st & 1) * 32 + (swz % 64) / 2; }
__host__ __device__ __forceinline__ int perm32(int rho) { const int n = rho >> 4, i = rho & 15; return 8 * (i >> 2) + 4 * n + (i & 3); }

struct Unit { int pm, pn; };
struct Gemm { const bf16_t* A; const bf16_t* Bt; int M, N, K; };

struct StaticOrder {
    int nM, nN, nwg, G, c;
    __host__ __device__ void init(int M, int N, int G_, int c_) { nM = M / BM; nN = N / BM; nwg = nM * nN; G = G_; c = c_; }
    __host__ __device__ bool next(int i, Unit& u) const {
        const long L = (long)i * G + c; if (L >= nwg) return false;
        int wgid = (int)L; { const int q = nwg / NXCD, r = nwg % NXCD, xcd = wgid % NXCD, off = wgid / NXCD; wgid = (xcd < r ? xcd * (q + 1) : r * (q + 1) + (xcd - r) * q) + off; }
        const int nig = WGM * nN, gid = wgid / nig, fm = gid * WGM, gsz = (nM - fm) < WGM ? (nM - fm) : WGM;
        u.pm = fm + ((wgid % nig) % gsz); u.pn = (wgid % nig) / gsz; return true;
    }
    __device__ __forceinline__ void a_ready(const Unit&) const {}
    __device__ __forceinline__ void done(const Unit&) const {}
};

__device__ __forceinline__ unsigned cvt_pk_bf16(float lo, float hi) { unsigned r; asm volatile("v_cvt_pk_bf16_f32 %0, %1, %2" : "=v"(r) : "v"(lo), "v"(hi)); return r; }
template <int ACT> struct EpiBf16 {
    static constexpr bool PERM = true, AFTER_DRAIN = false;
    bf16_t* O; int ldc;
    __device__ __forceinline__ void operator()(const f32x4 (&acc)[2][2][4][2], const Unit& u, int wr, int wc, int fr, int fq) const {
        const int row0 = u.pm * BM + wr * 64 + fr; const int col0 = u.pn * BM + wc * 32 + 8 * fq;
#pragma unroll
        for (int ai = 0; ai < 2; ++ai)
#pragma unroll
            for (int m = 0; m < 4; ++m) { bf16_t* rowp = O + (size_t)(row0 + ai * HALF + m * 16) * ldc + col0;
#pragma unroll
                for (int bj = 0; bj < 2; ++bj) { f32x4 v0 = acc[ai][bj][m][0], v1 = acc[ai][bj][m][1];
                    if (ACT == 2) {
#pragma unroll
                        for (int e = 0; e < 4; ++e) { const float a = fmaxf(v0[e], 0.f), b = fmaxf(v1[e], 0.f); v0[e] = a * a; v1[e] = b * b; } }
                    u32x4 w; w.x = cvt_pk_bf16(v0[0], v0[1]); w.y = cvt_pk_bf16(v0[2], v0[3]); w.z = cvt_pk_bf16(v1[0], v1[1]); w.w = cvt_pk_bf16(v1[2], v1[3]);
                    *(u32x4*)(rowp + bj * HALF) = w; } }
    }
};
struct EpiResGate {
    static constexpr bool PERM = false, AFTER_DRAIN = false;
    const float* xin; float* out; const float* gate;
    __device__ __forceinline__ void operator()(const f32x4 (&acc)[2][2][4][2], const Unit& u, int wr, int wc, int fr, int fq) const {
        const int b = (u.pm * BM) >> 11; const int col0 = u.pn * BM + wc * 32 + 4 * fq;
        f32x4 gv[2][2];
#pragma unroll
        for (int bj = 0; bj < 2; ++bj)
#pragma unroll
            for (int n = 0; n < 2; ++n) gv[bj][n] = *(const f32x4*)(gate + (size_t)b * 6144 + col0 + bj * HALF + n * 16);
#pragma unroll
        for (int ai = 0; ai < 2; ++ai)
#pragma unroll
            for (int m = 0; m < 4; ++m) { const size_t off = (size_t)(u.pm * BM + ai * HALF + wr * 64 + m * 16 + fr) * 1024 + col0;
#pragma unroll
                for (int bj = 0; bj < 2; ++bj)
#pragma unroll
                    for (int n = 0; n < 2; ++n) { const f32x4 xv = *(const f32x4*)(xin + off + bj * HALF + n * 16);
                        *(f32x4*)(out + off + bj * HALF + n * 16) = xv + gv[bj][n] * acc[ai][bj][m][n]; }
                asm volatile("" ::: "memory"); }
    }
};
template <class Epi, class Sched, bool ALIGN_EPI = false, bool SP2 = false>
__device__ __forceinline__ void gemm_phase(PG8_LAS unsigned char* lds, const Gemm g, const Sched& S, const Epi& E) {
    int tid_ = threadIdx.x; asm volatile("" : "+v"(tid_));
    const int tid = tid_, wid = __builtin_amdgcn_readfirstlane(tid >> 6), lane = tid & 63, wr = wid >> 2, wc = wid & 3, fr = lane & 15, fq = lane >> 4;
    const int K = g.K, nt = K / BK;
    unsigned voffA[2], voffB[2];
#pragma unroll
    for (int i = 0; i < 2; ++i) { int R, C; stage_rc(tid * 16 + i * 8192, R, C); const int Rb = Epi::PERM ? ((R & ~31) + perm32(R & 31)) : R;
        voffA[i] = (unsigned)(R * K + C) * 2u; voffB[i] = (unsigned)(Rb * K + C) * 2u; }
    const size_t kstep = (size_t)(BK * 2);
    const size_t hstep = (size_t)HALF * K * 2;
    const size_t tstep = 2 * hstep;
    const unsigned ldsw = (unsigned)wid * 1024u;
    const int aoff = lds_byte(wr * 64 + fr, fq * 8), boff = lds_byte(wc * 32 + fr, fq * 8);
#define PG8_SA(b, h) (((b) * 2 + (h)) * HTB)
#define PG8_SB(b, h) ((4 + (b) * 2 + (h)) * HTB)
#define PG8_STAGE(bufoff, gbase, voff) do { _Pragma("unroll") for (int _i = 0; _i < 2; ++_i) \
        __builtin_amdgcn_global_load_lds((const unsigned*)((const char*)(gbase) + (voff)[_i]), (PG8_LAS unsigned*)(lds + (bufoff) + ldsw + _i * 8192), 16, 0, 0); } while (0)
#define PG8_LDA(dst, b, h) do { _Pragma("unroll") for (int m = 0; m < 4; ++m) _Pragma("unroll") for (int k = 0; k < 2; ++k) dst[m][k] = *(const PG8_LAS bf16x8*)(lds + PG8_SA(b, h) + aoff + m * 2048 + k * 1024); } while (0)
#define PG8_LDB(dst, b, h) do { _Pragma("unroll") for (int n = 0; n < 2; ++n) _Pragma("unroll") for (int k = 0; k < 2; ++k) dst[n][k] = *(const PG8_LAS bf16x8*)(lds + PG8_SB(b, h) + boff + n * 2048 + k * 1024); } while (0)
#define PG8_MMA(ai, bj, At, Bt) do { __builtin_amdgcn_s_setprio(1); _Pragma("unroll") for (int m = 0; m < 4; ++m) _Pragma("unroll") for (int n = 0; n < 2; ++n) _Pragma("unroll") for (int k = 0; k < 2; ++k) \
        acc[ai][bj][m][n] = __builtin_amdgcn_mfma_f32_16x16x32_bf16(Bt[n][k], At[m][k], acc[ai][bj][m][n], 0, 0, 0); __builtin_amdgcn_s_setprio(0); } while (0)
#define PG8_WAIT_V(n) asm volatile("s_waitcnt vmcnt(" #n ")" ::: "memory")
#define PG8_WAIT_L(n) asm volatile("s_waitcnt lgkmcnt(" #n ")" ::: "memory")
#define PG8_BAR __builtin_amdgcn_s_barrier()
#define PG8_SCHED __builtin_amdgcn_sched_barrier(0)
    Unit cur, nxt; int ui = 0;
    if (!S.next(0, cur)) return;
    f32x4 acc[2][2][4][2];
#pragma unroll
    for (int a = 0; a < 2; ++a)
#pragma unroll
        for (int b = 0; b < 2; ++b)
#pragma unroll
            for (int m = 0; m < 4; ++m)
#pragma unroll
                for (int n = 0; n < 2; ++n) acc[a][b][m][n] = (f32x4){0.f, 0.f, 0.f, 0.f};
    bf16x8 At[4][2], B0[2][2], B1[2][2];
    const char* cA = (const char*)g.A + (size_t)cur.pm * tstep; const char* cB = (const char*)g.Bt + (size_t)cur.pn * tstep;
    S.a_ready(cur);
    if constexpr (SP2) {
        PG8_STAGE(PG8_SB(0, 0), cB, voffB); PG8_STAGE(PG8_SB(0, 1), cB + hstep, voffB); PG8_STAGE(PG8_SA(0, 0), cA, voffA); PG8_STAGE(PG8_SA(0, 1), cA + hstep, voffA);
        if (wr == 1) PG8_BAR;
        PG8_WAIT_V(2); PG8_BAR;
        PG8_STAGE(PG8_SB(1, 0), cB + kstep, voffB); PG8_STAGE(PG8_SA(1, 0), cA + kstep, voffA); PG8_STAGE(PG8_SB(1, 1), cB + hstep + kstep, voffB);
        PG8_WAIT_V(6); PG8_BAR;
    } else {
        PG8_STAGE(PG8_SB(0, 0), cB, voffB); PG8_STAGE(PG8_SA(0, 0), cA, voffA); PG8_STAGE(PG8_SB(0, 1), cB + hstep, voffB); PG8_STAGE(PG8_SA(0, 1), cA + hstep, voffA);
        if (wr == 1) PG8_BAR;
        PG8_WAIT_V(4); PG8_BAR;
        PG8_STAGE(PG8_SB(1, 0), cB + kstep, voffB); PG8_STAGE(PG8_SA(1, 0), cA + kstep, voffA); PG8_STAGE(PG8_SB(1, 1), cB + hstep + kstep, voffB);
        PG8_WAIT_V(6); PG8_BAR;
    }
    for (;;) {
        const bool has_next = S.next(ui + 1, nxt);
        const char* nA = has_next ? (const char*)g.A + (size_t)nxt.pm * tstep : cA; const char* nB = has_next ? (const char*)g.Bt + (size_t)nxt.pn * tstep : cB;
        for (int t = 0; t < nt; t += 2) {
            const bool last = (t == nt - 2);
            const char* a1 = cA + (size_t)(t + 1) * kstep;
            const char* a2 = last ? nA : cA + (size_t)(t + 2) * kstep; const char* b2 = last ? nB : cB + (size_t)(t + 2) * kstep;
            const char* a3 = a2 + kstep; const char* b3 = b2 + kstep;
            if (last && has_next) S.a_ready(nxt);
            if constexpr (SP2) {
            PG8_LDB(B0, 0, 0); PG8_LDB(B1, 0, 1); PG8_SCHED; PG8_LDA(At, 0, 0); PG8_STAGE(PG8_SA(1, 1), a1 + hstep, voffA);
            PG8_WAIT_V(8); PG8_WAIT_L(0); PG8_BAR; PG8_MMA(0, 0, At, B0); PG8_MMA(0, 1, At, B1); PG8_BAR; PG8_SCHED;
            PG8_LDA(At, 0, 1); PG8_STAGE(PG8_SB(0, 0), b2, voffB); PG8_STAGE(PG8_SB(0, 1), b2 + hstep, voffB); PG8_STAGE(PG8_SA(0, 0), a2, voffA);
            PG8_WAIT_V(8); PG8_WAIT_L(0); PG8_BAR; PG8_MMA(1, 0, At, B0); PG8_MMA(1, 1, At, B1); PG8_BAR; PG8_SCHED;
            PG8_LDB(B0, 1, 0); PG8_LDB(B1, 1, 1); PG8_SCHED; PG8_LDA(At, 1, 0); PG8_STAGE(PG8_SA(0, 1), a2 + hstep, voffA);
            PG8_WAIT_V(8); PG8_WAIT_L(0); PG8_BAR; PG8_MMA(0, 0, At, B0); PG8_MMA(0, 1, At, B1); PG8_BAR; PG8_SCHED;
            PG8_LDA(At, 1, 1); PG8_STAGE(PG8_SB(1, 0), b3, voffB); PG8_STAGE(PG8_SB(1, 1), b3 + hstep, voffB); PG8_STAGE(PG8_SA(1, 0), a3, voffA);
            PG8_WAIT_V(8); PG8_WAIT_L(0); PG8_BAR; PG8_MMA(1, 0, At, B0); PG8_MMA(1, 1, At, B1); PG8_BAR; PG8_SCHED;
            } else {
            PG8_LDB(B0, 0, 0); PG8_SCHED; PG8_LDA(At, 0, 0); PG8_STAGE(PG8_SA(1, 1), a1 + hstep, voffA);
            PG8_WAIT_L(8); PG8_BAR; PG8_WAIT_L(0); PG8_MMA(0, 0, At, B0); PG8_BAR; PG8_SCHED;
            PG8_LDB(B1, 0, 1); PG8_STAGE(PG8_SB(0, 0), b2, voffB);
            PG8_BAR; PG8_WAIT_L(0); PG8_MMA(0, 1, At, B1); PG8_BAR;
            PG8_LDA(At, 0, 1); PG8_STAGE(PG8_SA(0, 0), a2, voffA);
            PG8_BAR; PG8_WAIT_L(0); PG8_MMA(1, 0, At, B0); PG8_BAR; PG8_SCHED;
            PG8_STAGE(PG8_SB(0, 1), b2 + hstep, voffB);
            PG8_WAIT_V(6); PG8_BAR; PG8_MMA(1, 1, At, B1); PG8_BAR;
            PG8_LDB(B0, 1, 0); PG8_SCHED; PG8_LDA(At, 1, 0); PG8_STAGE(PG8_SA(0, 1), a2 + hstep, voffA);
            PG8_WAIT_L(8); PG8_BAR; PG8_WAIT_L(0); PG8_MMA(0, 0, At, B0); PG8_BAR; PG8_SCHED;
            PG8_LDB(B1, 1, 1); PG8_STAGE(PG8_SB(1, 0), b3, voffB);
            PG8_BAR; PG8_WAIT_L(0); PG8_MMA(0, 1, At, B1); PG8_BAR;
            PG8_LDA(At, 1, 1); PG8_STAGE(PG8_SA(1, 0), a3, voffA);
            PG8_BAR; PG8_WAIT_L(0); PG8_MMA(1, 0, At, B0); PG8_BAR; PG8_SCHED;
            PG8_STAGE(PG8_SB(1, 1), b3 + hstep, voffB);
            PG8_WAIT_V(6); PG8_BAR; PG8_MMA(1, 1, At, B1); PG8_BAR;
            }
        }
        if constexpr (ALIGN_EPI) { if (wr == 0) PG8_BAR; }
        if constexpr (!Epi::AFTER_DRAIN) { E(acc, cur, wr, wc, fr, fq); S.done(cur); }
        if (!has_next) break;
#pragma unroll
        for (int a = 0; a < 2; ++a)
#pragma unroll
            for (int b = 0; b < 2; ++b)
#pragma unroll
                for (int m = 0; m < 4; ++m)
#pragma unroll
                    for (int n = 0; n < 2; ++n) acc[a][b][m][n] = (f32x4){0.f, 0.f, 0.f, 0.f};
        cur = nxt; cA = nA; cB = nB; ++ui;
        if constexpr (ALIGN_EPI) { if (wr == 1) PG8_BAR; }
    }
    PG8_WAIT_V(0);
    if constexpr (!ALIGN_EPI) { if (wr == 0) PG8_BAR; }
    PG8_BAR;
    if constexpr (Epi::AFTER_DRAIN) { E.fused(acc, cur, wr, wc, fr, fq, lds, wid, lane); S.done(cur); }
#undef PG8_SA
#undef PG8_SB
#undef PG8_STAGE
#undef PG8_LDA
#undef PG8_LDB
#undef PG8_MMA
#undef PG8_WAIT_V
#undef PG8_WAIT_L
#undef PG8_BAR
#undef PG8_SCHED
}
}

#ifndef PG8_SP2
#define PG8_SP2 true
#endif
#ifndef PG8_ALIGN
#define PG8_ALIGN true
#endif
#include <hip/hip_bf16.h>
#include <cmath>
namespace attn_body {
using bf16=__hip_bfloat16;
using bf16x8=__attribute__((ext_vector_type(8)))short;
using s16x4=__attribute__((ext_vector_type(4)))short;
using f32x16=__attribute__((ext_vector_type(16)))float;
using u32x4=__attribute__((ext_vector_type(4)))unsigned;
constexpr int SEQ=2048,D=64;
constexpr int NW=8,QBLK=32,QB=QBLK*NW,KVBLK=64,NQB=SEQ/QB;
__device__ __forceinline__ int crow(int r,int hi){return (r&3)+8*(r>>2)+4*hi;}
#define SBAR() __builtin_amdgcn_sched_barrier(0)
constexpr int NSLOT=3, SLOTB=8192;
constexpr int LDS_K=0, LDS_V=NSLOT*SLOTB, LDS_WS=2*NSLOT*SLOTB, LDS_OST=LDS_WS+NW*64*4, LDS_STASH=LDS_OST+NW*4096, LDS_BYTES=LDS_STASH+NW*8192;
constexpr float LOG2E=1.4426950408889634f;
__device__ __forceinline__ void glds16(const void*gsrc,unsigned lds_dst){unsigned keep;
  asm volatile("s_mov_b32 %0, m0\n\ts_mov_b32 m0, %2\n\ts_nop 0\n\tglobal_load_lds_dwordx4 %1, off\n\ts_mov_b32 m0, %0":"=&s"(keep):"v"(gsrc),"s"(lds_dst):"memory");}
__device__ __forceinline__ float max3f(float a,float b,float c){float r;asm("v_max3_f32 %0, %1, %2, %3":"=v"(r):"v"(a),"v"(b),"v"(c));return r;}
__device__ __forceinline__ float max2f(float a,float b){float r;asm("v_max_f32_e32 %0, %1, %2":"=v"(r):"v"(a),"v"(b));return r;}
__device__ __forceinline__ float fadd_s(float a,float b){float r;asm("v_add_f32_e32 %0, %1, %2":"=v"(r):"v"(a),"v"(b));return r;}
__device__ __forceinline__ float fsub_s(float a,float b){float r;asm("v_sub_f32_e32 %0, %1, %2":"=v"(r):"v"(a),"v"(b));return r;}
typedef float f32x2_t __attribute__((ext_vector_type(2))); typedef __bf16 bf16x2_t __attribute__((ext_vector_type(2)));
__device__ __forceinline__ unsigned cvtpk_s(float lo,float hi){f32x2_t v={lo,hi};bf16x2_t b=__builtin_convertvector(v,bf16x2_t);return __builtin_bit_cast(unsigned,b);}
#define WAIT_BAR(N) asm volatile("s_waitcnt vmcnt(" #N ") lgkmcnt(0)\n\ts_barrier":::"memory")

__device__ __forceinline__ void qkt(f32x16&p0,f32x16&p1,const char*Kslot,const bf16x8*qr,const f32x16&negm,int r32,int hi){
  const char*kb=Kslot+hi*1024+r32*16;
  #pragma unroll
  for(int d0=0;d0<4;++d0){
    const bf16x8 b0=*reinterpret_cast<const bf16x8*>(kb+d0*2048);
    const bf16x8 b1=*reinterpret_cast<const bf16x8*>(kb+d0*2048+512);
    if(d0==0){p0=__builtin_amdgcn_mfma_f32_32x32x16_bf16(b0,qr[0],negm,0,0,0);p1=__builtin_amdgcn_mfma_f32_32x32x16_bf16(b1,qr[0],negm,0,0,0);}
    else{p0=__builtin_amdgcn_mfma_f32_32x32x16_bf16(b0,qr[d0],p0,0,0,0);p1=__builtin_amdgcn_mfma_f32_32x32x16_bf16(b1,qr[d0],p1,0,0,0);}}
}
typedef __attribute__((address_space(3))) const char* lds_cptr;
typedef short v4i16_t __attribute__((ext_vector_type(4)));
__device__ __forceinline__ void kload8(bf16x8*kf,lds_cptr kp){
  kf[0]=*(const __attribute__((address_space(3))) bf16x8*)(kp);      kf[1]=*(const __attribute__((address_space(3))) bf16x8*)(kp+512);
  kf[2]=*(const __attribute__((address_space(3))) bf16x8*)(kp+2048); kf[3]=*(const __attribute__((address_space(3))) bf16x8*)(kp+2560);
  kf[4]=*(const __attribute__((address_space(3))) bf16x8*)(kp+4096); kf[5]=*(const __attribute__((address_space(3))) bf16x8*)(kp+4608);
  kf[6]=*(const __attribute__((address_space(3))) bf16x8*)(kp+6144); kf[7]=*(const __attribute__((address_space(3))) bf16x8*)(kp+6656);
}
__device__ __forceinline__ void kload2(bf16x8*kf,lds_cptr kp,int j){ kf[2*j]=*(const __attribute__((address_space(3))) bf16x8*)(kp+j*2048); kf[2*j+1]=*(const __attribute__((address_space(3))) bf16x8*)(kp+j*2048+512); }
__device__ __forceinline__ s16x4 vtr(lds_cptr p){ return __builtin_bit_cast(s16x4,__builtin_amdgcn_ds_read_tr16_b64_v4i16((__attribute__((address_space(3))) v4i16_t*)p)); }
__device__ __forceinline__ float rowmax(const f32x16&p0,const f32x16&p1){
  float a=max3f(p0[0],p0[1],p1[0]),b=max3f(p0[2],p0[3],p1[1]);a=max3f(a,p1[2],p1[3]);
  #pragma unroll
  for(int r=4;r<16;r+=4){a=max3f(a,p0[r],p0[r+1]);b=max3f(b,p0[r+2],p0[r+3]);a=max3f(a,p1[r],p1[r+1]);b=max3f(b,p1[r+2],p1[r+3]);}
  const float m=max2f(a,b);
  auto rr=__builtin_amdgcn_permlane32_swap(__float_as_uint(m),__float_as_uint(m),false,false);
  return max2f(__uint_as_float(rr[0]),__uint_as_float(rr[1]));
}
__device__ __forceinline__ void pv(f32x16*o,int vb,bf16x8 pa0,bf16x8 pa1,bf16x8 pa2,bf16x8 pa3){
  #pragma unroll
  for(int d0=0;d0<2;++d0){s16x4 lo[4],hi[4];
    #pragma unroll
    for(int ks=0;ks<4;++ks){
      asm volatile("ds_read_b64_tr_b16 %0,%1 offset:%c2":"=&v"(lo[ks]):"v"(vb),"i"(d0*4096+ks*1024):"memory");
      asm volatile("ds_read_b64_tr_b16 %0,%1 offset:%c2":"=&v"(hi[ks]):"v"(vb),"i"(d0*4096+ks*1024+512):"memory");}
    asm volatile("s_waitcnt lgkmcnt(0)":::"memory");SBAR();
    #define PK(k) (bf16x8){lo[k][0],lo[k][1],lo[k][2],lo[k][3],hi[k][0],hi[k][1],hi[k][2],hi[k][3]}
    o[d0]=__builtin_amdgcn_mfma_f32_32x32x16_bf16(pa0,PK(0),o[d0],0,0,0);
    o[d0]=__builtin_amdgcn_mfma_f32_32x32x16_bf16(pa1,PK(1),o[d0],0,0,0);
    o[d0]=__builtin_amdgcn_mfma_f32_32x32x16_bf16(pa2,PK(2),o[d0],0,0,0);
    o[d0]=__builtin_amdgcn_mfma_f32_32x32x16_bf16(pa3,PK(3),o[d0],0,0,0);
    #undef PK
  }
}
struct AttnJob { const bf16* Q; int qp; const bf16* K; int kp; const bf16* V; int vp; bf16* O; int op; int npass; float lam; const float* gain; float oscale; };
typedef float f32x4a __attribute__((ext_vector_type(4)));
template<int THRL> __device__ __forceinline__ void attn_unit(const AttnJob& J,char*shm){
 for(int pass=0;pass<J.npass;++pass){
  int tid_=threadIdx.x; asm volatile("":"+v"(tid_)); const int tid=tid_,lane=tid&63,r32=lane&31,hi=lane>>5; const int wid=__builtin_amdgcn_readfirstlane(tid>>6);
  const bf16*Qw=J.Q+(long)(wid*QBLK)*J.qp+pass*64;
  const bf16*Kh=J.K,*Vh=J.V;
  const unsigned lds0=(unsigned)(uintptr_t)shm;
  float*wsf=(float*)(shm+LDS_WS)+wid*64;
  const bf16*ksrc=Kh+(long)lane*J.kp+wid*8;
  const bf16*vsrc=Vh+(long)(16*(wid&3)+(lane>>2))*J.vp+(wid>>2)*32+(lane&3)*8;
  const unsigned kdst=lds0+LDS_K+wid*1024, vdst=lds0+LDS_V+wid*1024;
  #define DMA_K(t,slot) glds16(ksrc+(long)(t)*KVBLK*J.kp,(unsigned)__builtin_amdgcn_readfirstlane(kdst+(slot)))
  #define DMA_V(t,slot) glds16(vsrc+(long)(t)*KVBLK*J.vp,(unsigned)__builtin_amdgcn_readfirstlane(vdst+(slot)))
  const int vb0=(int)(lds0+LDS_V)+((lane>>4)&1)*32+(lane&3)*8+(4*hi+((lane&15)>>2))*64;
  const char*Kbase=shm+LDS_K; bf16x8 kf[8];
  const lds_cptr shm3=(lds_cptr)shm; const lds_cptr kp0=shm3+LDS_K+hi*1024+r32*16; const lds_cptr vp0=shm3+LDS_V+((lane>>4)&1)*32+(lane&3)*8+(4*hi+((lane&15)>>2))*64;
  constexpr int NT=SEQ/KVBLK;
  DMA_K(0,0);DMA_V(0,0);DMA_K(1,SLOTB);
  bf16x8 qr[4];
  #pragma unroll
  for(int d0=0;d0<4;++d0)qr[d0]=*reinterpret_cast<const bf16x8*>(&Qw[(long)r32*J.qp+d0*16+hi*8]);
  float mhat=0.f,l_reg=0.f;f32x16 o[2];o[0]=f32x16{};o[1]=f32x16{};f32x16 negm=f32x16{};asm volatile("":"+v"(negm));
  #define CMASK(P0,P1,t) do{}while(0)
  bool resc=false;
  #define START(P0,P1) do{ const float rm=rowmax(P0,P1); resc=false; \
    { const float dl=rm; mhat=fadd_s(mhat,dl); \
      _Pragma("unroll") for(int r=0;r<16;++r){P0[r]=fsub_s(P0[r],dl);P1[r]=fsub_s(P1[r],dl);} \
      _Pragma("unroll") for(int r=0;r<16;++r)negm[r]=-mhat; asm volatile("":"+v"(negm)); } \
    _Pragma("unroll") for(int r=0;r<16;++r)P0[r]=__builtin_amdgcn_exp2f(P0[r]); }while(0)
  #define RESC() do{ if(resc){ asm volatile("s_waitcnt lgkmcnt(0)":::"memory"); \
      _Pragma("unroll") for(int d_=0;d_<2;++d_) _Pragma("unroll") for(int r=0;r<16;++r)o[d_][r]*=wsf[crow(r,hi)]; } }while(0)
  f32x16 pA0,pA1,pB0,pB1;
  int sl_prev=0,sl_cur=0,sl_next=SLOTB;
  #define ROT() do{sl_prev=sl_cur;sl_cur=sl_next;sl_next=(sl_next==(NSLOT-1)*SLOTB)?0:sl_next+SLOTB;}while(0)
  DMA_K(2,2*SLOTB);
  WAIT_BAR(3);
  qkt(pA0,pA1,Kbase,qr,negm,r32,hi);asm volatile("s_nop 15\n\ts_nop 7":"+v"(pA0),"+v"(pA1));CMASK(pA0,pA1,0);
  START(pA0,pA1);
  _Pragma("unroll") for(int r=0;r<16;++r)pA1[r]=__builtin_amdgcn_exp2f(pA1[r]);
  WAIT_BAR(0);
  DMA_K(3,0);DMA_V(1,SLOTB);
  ROT();
  kload8(kf,kp0+sl_cur);
  WAIT_BAR(2);
  s16x4 vlo[8],vhi[8]; u32x4 pw0,pw1,pw2,pw3;
  #define PKW(P,B) cvtpk_s(P[B],P[B+1])
  #define PAF(k) __builtin_bit_cast(bf16x8,pw##k)
  #define VFR(i) (bf16x8){vlo[i][0],vlo[i][1],vlo[i][2],vlo[i][3],vhi[i][0],vhi[i][1],vhi[i][2],vhi[i][3]}
  #define PIN(x) asm volatile("":"+v"(x))
  #define MX3(a,b,c) __builtin_fmaxf(__builtin_fmaxf((a),(b)),(c))
  #define GAPA(MF,A0,A1,A2,A3,W0,W1,PW) do{ MF; sacc+=A0; sacc+=A1; sacc+=A2; sacc+=A3; PIN(sacc); W0; W1; PIN(PW); SBAR(); }while(0)
  #define EX(v) __builtin_amdgcn_exp2f(v)
  #define GAPB(MF,X,B) do{ MF; X[B]=EX(X[B]); X[B+1]=EX(X[B+1]); X[B+2]=EX(X[B+2]); X[B+3]=EX(X[B+3]); PIN(X); SBAR(); }while(0)
  #define VRD(i) do{ vlo[i]=vtr(vp_+(((i)>>2)*4096+((i)&3)*1024)); vhi[i]=vtr(vp_+(((i)>>2)*4096+((i)&3)*1024+512)); }while(0)
  #define KRD(G,j) do{ if(G){ kload2(kf,kp0+sl_next,j); SBAR(); } }while(0)
  #define STEP(C0,C1,P0,P1,t,GK,GV,GL) do{ SBAR(); \
    const lds_cptr vp_=vp0+sl_prev; \
    VRD(0); SBAR(); float sacc=(P0[0]+P0[1]); \
    GAPA(C0=__builtin_amdgcn_mfma_f32_32x32x16_bf16(kf[0],qr[0],negm,0,0,0), P0[2],P0[3],P0[4],P0[5],     pw0[0]=PKW(P0,0), pw0[1]=PKW(P0,2), pw0); \
    VRD(4); SBAR(); GAPA(C1=__builtin_amdgcn_mfma_f32_32x32x16_bf16(kf[1],qr[0],negm,0,0,0), P0[6],P0[7],P0[8],P0[9],     pw0[2]=PKW(P0,4), pw0[3]=PKW(P0,6), pw0); \
    VRD(1); SBAR(); GAPA(C0=__builtin_amdgcn_mfma_f32_32x32x16_bf16(kf[2],qr[1],C0,0,0,0),   P0[10],P0[11],P0[12],P0[13], pw1[0]=PKW(P0,8), pw1[1]=PKW(P0,10), pw1); \
    VRD(5); SBAR(); GAPA(C1=__builtin_amdgcn_mfma_f32_32x32x16_bf16(kf[3],qr[1],C1,0,0,0),   P0[14],P0[15],P1[0],P1[1],   pw1[2]=PKW(P0,12),pw1[3]=PKW(P0,14), pw1); \
    VRD(2); SBAR(); GAPA(C0=__builtin_amdgcn_mfma_f32_32x32x16_bf16(kf[4],qr[2],C0,0,0,0),   P1[2],P1[3],P1[4],P1[5],     pw2[0]=PKW(P1,0), pw2[1]=PKW(P1,2), pw2); \
    VRD(6); SBAR(); GAPA(C1=__builtin_amdgcn_mfma_f32_32x32x16_bf16(kf[5],qr[2],C1,0,0,0),   P1[6],P1[7],P1[8],P1[9],     pw2[2]=PKW(P1,4), pw2[3]=PKW(P1,6), pw2); \
    VRD(3); SBAR(); GAPA(C0=__builtin_amdgcn_mfma_f32_32x32x16_bf16(kf[6],qr[3],C0,0,0,0),   P1[10],P1[11],P1[12],P1[13], pw3[0]=PKW(P1,8), pw3[1]=PKW(P1,10), pw3); \
    VRD(7); SBAR(); GAPA(C1=__builtin_amdgcn_mfma_f32_32x32x16_bf16(kf[7],qr[3],C1,0,0,0),   P1[14],P1[15],0.f,0.f,       pw3[2]=PKW(P1,12),pw3[3]=PKW(P1,14), pw3); \
    l_reg+=sacc; \
    if(GK){DMA_K((t)+3,sl_cur);} if(GV){DMA_V((t)+1,sl_next);} \
    CMASK(C0,C1,t); \
    { float a=MX3(C0[0],C0[1],C1[0]),b=MX3(C0[2],C0[3],C1[1]); a=MX3(a,C1[2],C1[3]); \
      _Pragma("unroll") for(int r=4;r<16;r+=4){a=MX3(a,C0[r],C0[r+1]);b=MX3(b,C0[r+2],C0[r+3]);a=MX3(a,C1[r],C1[r+1]);b=MX3(b,C1[r+2],C1[r+3]);} \
      float rm=__builtin_fmaxf(a,b); { auto rr=__builtin_amdgcn_permlane32_swap(__float_as_uint(rm),__float_as_uint(rm),false,false); rm=__builtin_fmaxf(__uint_as_float(rr[0]),__uint_as_float(rr[1])); } \
      resc=false; \
      if(__builtin_expect(__any(rm>(float)THRL),0)){ const float dl=__builtin_fmaxf(rm,0.f); mhat+=dl; \
        _Pragma("unroll") for(int r=0;r<16;++r){C0[r]-=dl;C1[r]-=dl;} \
        _Pragma("unroll") for(int r=0;r<16;++r)negm[r]=-mhat; asm volatile("":"+v"(negm)); \
        const float f=__builtin_amdgcn_exp2f(-dl); l_reg*=f; if(hi==0)wsf[r32]=f; resc=true; } } \
    SBAR(); \
    GAPB(o[0]=__builtin_amdgcn_mfma_f32_32x32x16_bf16(PAF(0),VFR(0),o[0],0,0,0), C0,0); \
    GAPB(o[1]=__builtin_amdgcn_mfma_f32_32x32x16_bf16(PAF(0),VFR(4),o[1],0,0,0), C0,4); \
    KRD(GL,0); GAPB(o[0]=__builtin_amdgcn_mfma_f32_32x32x16_bf16(PAF(1),VFR(1),o[0],0,0,0), C0,8); \
    KRD(GL,1); GAPB(o[1]=__builtin_amdgcn_mfma_f32_32x32x16_bf16(PAF(1),VFR(5),o[1],0,0,0), C0,12); \
    KRD(GL,2); GAPB(o[0]=__builtin_amdgcn_mfma_f32_32x32x16_bf16(PAF(2),VFR(2),o[0],0,0,0), C1,0); \
    KRD(GL,3); GAPB(o[1]=__builtin_amdgcn_mfma_f32_32x32x16_bf16(PAF(2),VFR(6),o[1],0,0,0), C1,4); \
    GAPB(o[0]=__builtin_amdgcn_mfma_f32_32x32x16_bf16(PAF(3),VFR(3),o[0],0,0,0), C1,8); \
    GAPB(o[1]=__builtin_amdgcn_mfma_f32_32x32x16_bf16(PAF(3),VFR(7),o[1],0,0,0), C1,12); \
    }while(0)
  int t=1;
  #undef CMASK
  #define CMASK(P0,P1,t) do{}while(0)
  for(;t+5<NT;t+=2){
    STEP(pB0,pB1,pA0,pA1,t,true,true,true);     WAIT_BAR(2); RESC(); ROT();
    STEP(pA0,pA1,pB0,pB1,t+1,true,true,true);   WAIT_BAR(2); RESC(); ROT();
  }
  #undef CMASK
  #define CMASK(P0,P1,t) do{}while(0)
  #define ENDW(tt) do{ if((tt)+3<NT){WAIT_BAR(2);} else if((tt)+2<NT){WAIT_BAR(1);} else {WAIT_BAR(0);} }while(0)
  for(;t+1<NT;t+=2){
    STEP(pB0,pB1,pA0,pA1,t,(t+3<NT),(t+1<NT),(t+1<NT));       ENDW(t);   RESC(); ROT();
    STEP(pA0,pA1,pB0,pB1,t+1,(t+4<NT),(t+2<NT),(t+2<NT));     ENDW(t+1); RESC(); ROT();
  }
  STEP(pB0,pB1,pA0,pA1,NT-1,false,false,false); RESC();
  { float sacc=pB0[0]+pB0[1]; _Pragma("unroll") for(int r=2;r<16;++r)sacc+=pB0[r]; _Pragma("unroll") for(int r=0;r<16;++r)sacc+=pB1[r]; l_reg+=sacc;
    pw0=(u32x4){PKW(pB0,0),PKW(pB0,2),PKW(pB0,4),PKW(pB0,6)};pw1=(u32x4){PKW(pB0,8),PKW(pB0,10),PKW(pB0,12),PKW(pB0,14)};pw2=(u32x4){PKW(pB1,0),PKW(pB1,2),PKW(pB1,4),PKW(pB1,6)};pw3=(u32x4){PKW(pB1,8),PKW(pB1,10),PKW(pB1,12),PKW(pB1,14)};
    SBAR(); pv(o,vb0+sl_cur,PAF(0),PAF(1),PAF(2),PAF(3)); }
  #undef PKW
  #undef PAF
  #undef VFR
  #undef PIN
  #undef MX3
  #undef GAPA
  #undef GAPB
  #undef EX
  #undef VRD
  #undef KRD
  #undef STEP
  #undef ENDW
  {auto rr=__builtin_amdgcn_permlane32_swap(__float_as_uint(l_reg),__float_as_uint(l_reg),false,false);l_reg=__uint_as_float(rr[0])+__uint_as_float(rr[1]);}
  if(hi==0)wsf[32+r32]=l_reg;asm volatile("s_waitcnt lgkmcnt(0)":::"memory");
  float rli[16];
  #pragma unroll
  for(int r=0;r<16;++r)rli[r]=__builtin_amdgcn_rcpf(wsf[32+crow(r,hi)]);
  bf16*Ow=J.O+(long)(wid*QBLK)*J.op;
  if(J.npass==1){ bf16*stg=(bf16*)(shm+LDS_OST)+wid*2048;
    #pragma unroll
    for(int r=0;r<16;++r){const int orow=crow(r,hi);
      #pragma unroll
      for(int d0=0;d0<2;++d0)stg[orow*64+d0*32+r32]=__float2bfloat16(o[d0][r]*rli[r]);}
    asm volatile("s_waitcnt lgkmcnt(0)":::"memory");
    #pragma unroll
    for(int i=0;i<4;++i){const int row=i*8+(lane>>3),ch=lane&7; const u32x4 v=*(const u32x4*)(stg+row*64+ch*8); *(u32x4*)(Ow+(long)row*J.op+ch*8)=v;} }
  else { float*st=(float*)(shm+LDS_STASH)+wid*2048;
    if(pass==0){
      #pragma unroll
      for(int r=0;r<16;++r){
        #pragma unroll
        for(int d0=0;d0<2;++d0)st[(r*2+d0)*64+lane]=o[d0][r]*rli[r];}
    } else {
      float dv[2][16];
      #pragma unroll
      for(int r=0;r<16;++r){
        #pragma unroll
        for(int d0=0;d0<2;++d0)dv[d0][r]=st[(r*2+d0)*64+lane]-J.lam*(o[d0][r]*rli[r]);}
      asm volatile("s_waitcnt lgkmcnt(0)":::"memory");
      #pragma unroll
      for(int r=0;r<16;++r){const int orow=crow(r,hi);
        #pragma unroll
        for(int d0=0;d0<2;++d0)st[orow*64+d0*32+r32]=dv[d0][r];}
      asm volatile("s_waitcnt lgkmcnt(0)":::"memory");
      #pragma unroll
      for(int i=0;i<4;++i){const int row=i*8+(lane>>3),ch=lane&7;
        const f32x4a a=*(const f32x4a*)(st+row*64+ch*8), b2=*(const f32x4a*)(st+row*64+ch*8+4);
        float ss=(a[0]*a[0]+a[1]*a[1])+(a[2]*a[2]+a[3]*a[3])+(b2[0]*b2[0]+b2[1]*b2[1])+(b2[2]*b2[2]+b2[3]*b2[3]);
        ss+=__shfl_xor(ss,1);ss+=__shfl_xor(ss,2);ss+=__shfl_xor(ss,4);
        const float rs=rsqrtf(ss*(1.0f/64.0f)+1e-6f)*J.oscale;
        const f32x4a g0=*(const f32x4a*)(J.gain+ch*8), g1=*(const f32x4a*)(J.gain+ch*8+4);
        u32x4 v; v[0]=cvtpk_s(a[0]*rs*g0[0],a[1]*rs*g0[1]); v[1]=cvtpk_s(a[2]*rs*g0[2],a[3]*rs*g0[3]); v[2]=cvtpk_s(b2[0]*rs*g1[0],b2[1]*rs*g1[1]); v[3]=cvtpk_s(b2[2]*rs*g1[2],b2[3]*rs*g1[3]);
        *(u32x4*)(Ow+(long)row*J.op+ch*8)=v;}
    } }
  asm volatile("s_waitcnt lgkmcnt(0)\n\ts_barrier":::"memory");
  #undef DMA_K
  #undef DMA_V
  #undef CMASK
  #undef START
  #undef RESC
  #undef ROT
 }
}
constexpr int ATTN_LDS_BYTES=LDS_BYTES;
#undef SBAR
#undef WAIT_BAR
}
#define LAS __attribute__((address_space(3)))
typedef unsigned short bfu;
typedef unsigned v4u __attribute__((ext_vector_type(4)));
typedef unsigned v2u __attribute__((ext_vector_type(2)));
typedef float f32x4 __attribute__((ext_vector_type(4)));
typedef short bf16x8 __attribute__((ext_vector_type(8)));
constexpr int NWAVES = 8, NTHR = 512;
constexpr int BATCH = 32, SEQ = 2048, DM = 1024, M = BATCH * SEQ, NIN = 3072, DFF = 4096, NMOD = 6144;
constexpr size_t MiB = 1u << 20;
constexpr size_t WS_CTL = 0, CTL_ZERO_BYTES = 16384;
constexpr size_t WS_MOD = 1 * MiB;
constexpr size_t WS_ROPE = 3 * MiB;
constexpr size_t WS_WIN = 4 * MiB, WS_WOUT = 16 * MiB, WS_WFF1 = 20 * MiB, WS_WFF2 = 36 * MiB;
constexpr size_t WS_HN = 64 * MiB;
constexpr size_t WS_MIX = 192 * MiB;
constexpr size_t WS_OF = 320 * MiB;
constexpr size_t WS_SLAB = 384 * MiB, SLAB = 19 * MiB;
constexpr size_t SL_Z = 0, SL_QA = 12 * MiB, SL_KA = 12 * MiB + 1536 * 1024, SL_QB = 14 * MiB, SL_KB = 17 * MiB, SL_HID = 0;
constexpr size_t WS_END = WS_SLAB + 32 * SLAB;
static_assert(WS_END <= 1024 * MiB && SL_KB + 2048 * 384 * 2 <= SLAB && 2048 * 4096 * 2 <= SL_KB, "ws map");
constexpr int LDS_TOTAL = 149504;
static_assert(attn_body::ATTN_LDS_BYTES <= LDS_TOTAL && pg8::STAGE_BYTES <= LDS_TOTAL, "lds");

struct Params {
    const float *x, *c, *w_mod, *b_mod, *w_in, *a_qk_norm, *diff_lambda, *diff_subln, *hgrn_lb, *hgrn_norm, *w_out, *w_ff1, *w_ff2, *final_norm;
    float* out; unsigned char* ws;
};

__device__ __forceinline__ float bf2f(unsigned short u) { return __uint_as_float((unsigned)u << 16); }
__device__ __forceinline__ unsigned pkbf(float lo, float hi) { typedef float f2 __attribute__((ext_vector_type(2))); typedef __bf16 b2 __attribute__((ext_vector_type(2))); f2 v = {lo, hi}; b2 b = __builtin_convertvector(v, b2); return __builtin_bit_cast(unsigned, b); }
__device__ __forceinline__ unsigned short f2bf1(float x) { return (unsigned short)(pkbf(x, 0.f) & 0xffffu); }
__device__ __forceinline__ float wave_sum(float v) {
#pragma unroll
    for (int o = 1; o < 64; o <<= 1) v += __shfl_xor(v, o);
    return v;
}
__device__ __forceinline__ float sigmoidf_(float x) { return 1.0f / (1.0f + __expf(-x)); }

__device__ __forceinline__ void p0_transpose_item(const float* W, int K, int N, bfu* WT, LAS float* scr, int item, int lane) {
    const int nblk = N / 32, kb = item / nblk, nb = item % nblk, k0 = 64 * kb, n0 = 32 * nb;
#pragma unroll 8
    for (int i = 0; i < 32; ++i) { const int kk = 2 * i + (lane >> 5); scr[kk * 33 + (lane & 31)] = W[(size_t)(k0 + kk) * N + n0 + (lane & 31)]; }
    asm volatile("s_waitcnt lgkmcnt(0)" ::: "memory");
    const int c = lane & 7;
#pragma unroll
    for (int j = 0; j < 4; ++j) { const int n = (lane >> 3) + 8 * j; const LAS float* s = scr + (8 * c) * 33 + n;
        v4u o; o.x = pkbf(s[0 * 33], s[1 * 33]); o.y = pkbf(s[2 * 33], s[3 * 33]); o.z = pkbf(s[4 * 33], s[5 * 33]); o.w = pkbf(s[6 * 33], s[7 * 33]);
        *(v4u*)(WT + (size_t)(n0 + n) * K + k0 + 8 * c) = o; }
    asm volatile("s_waitcnt lgkmcnt(0)" ::: "memory");
}

__device__ __forceinline__ void phase_prologue(const Params& p, LAS unsigned char* lds, int tid, int lane, int wave) {
    const int G = gridDim.x;
    float* MOD = (float*)(p.ws + WS_MOD);
    LAS float* SC = (LAS float*)lds;
    for (int u = blockIdx.x; u < 2 * (NMOD / 64); u += G) {
        const int l = u / (NMOD / 64), cg0 = (u % (NMOD / 64)) * 64;
        for (int i = tid; i < BATCH * DM; i += NTHR) { const float cv = p.c[i]; SC[i] = cv * sigmoidf_(cv); }
        __syncthreads();
        float acc[32];
#pragma unroll
        for (int b = 0; b < 32; ++b) acc[b] = 0.f;
        const float* wp = p.w_mod + ((size_t)l * DM + wave * 128) * NMOD + cg0 + lane;
        for (int k4 = 0; k4 < 128; k4 += 4) {
            const float w0 = wp[(size_t)(k4 + 0) * NMOD], w1 = wp[(size_t)(k4 + 1) * NMOD], w2 = wp[(size_t)(k4 + 2) * NMOD], w3 = wp[(size_t)(k4 + 3) * NMOD];
#pragma unroll
            for (int b = 0; b < 32; ++b) { const f32x4 s = *(const LAS f32x4*)(SC + b * DM + wave * 128 + k4); acc[b] += s[0] * w0 + s[1] * w1 + s[2] * w2 + s[3] * w3; }
        }
        __syncthreads();
        LAS float* RED = (LAS float*)lds;
#pragma unroll
        for (int b = 0; b < 32; ++b) RED[(wave * 32 + b) * 64 + lane] = acc[b];
        __syncthreads();
#pragma unroll
        for (int bb = 0; bb < 4; ++bb) { const int b = wave * 4 + bb; float s = 0.f;
#pragma unroll
            for (int w = 0; w < 8; ++w) s += RED[(w * 32 + b) * 64 + lane];
            MOD[((size_t)l * BATCH + b) * NMOD + cg0 + lane] = s + p.b_mod[l * NMOD + cg0 + lane]; }
        __syncthreads();
    }
    {
        float* ROPE = (float*)(p.ws + WS_ROPE);
        for (int i = blockIdx.x * NTHR + tid; i < 2048 * 16; i += G * NTHR) {
            const int pos = i >> 4, j = i & 15;
            const double inv = exp2(-(double)j * (13.287712379549449 / 16.0));
            const double rev = (double)pos * inv * 0.15915494309189535;
            const float fr = (float)(rev - floor(rev));
            ROPE[2 * i] = __builtin_amdgcn_cosf(fr); ROPE[2 * i + 1] = __builtin_amdgcn_sinf(fr);
        }
    }
    {
        LAS float* scr = (LAS float*)(lds + wave * 16384);
        const int gw = blockIdx.x * NWAVES + wave, NGW = G * NWAVES;
        constexpr int I_IN = (DM / 64) * (NIN / 32), I_OUT = (DM / 64) * (DM / 32), I_F1 = (DM / 64) * (DFF / 32), I_F2 = (DFF / 64) * (DM / 32);
        constexpr int PER_L = I_IN + I_OUT + I_F1 + I_F2;
        for (int it = gw; it < 2 * PER_L; it += NGW) {
            const int l = it / PER_L; int r = it % PER_L;
            if (r < I_IN) { p0_transpose_item(p.w_in + (size_t)l * DM * NIN, DM, NIN, (bfu*)(p.ws + WS_WIN) + (size_t)l * NIN * DM, scr, r, lane); continue; } r -= I_IN;
            if (r < I_OUT) { p0_transpose_item(p.w_out + (size_t)l * DM * DM, DM, DM, (bfu*)(p.ws + WS_WOUT) + (size_t)l * DM * DM, scr, r, lane); continue; } r -= I_OUT;
            if (r < I_F1) { p0_transpose_item(p.w_ff1 + (size_t)l * DM * DFF, DM, DFF, (bfu*)(p.ws + WS_WFF1) + (size_t)l * DFF * DM, scr, r, lane); continue; } r -= I_F1;
            p0_transpose_item(p.w_ff2 + (size_t)l * DFF * DM, DFF, DM, (bfu*)(p.ws + WS_WFF2) + (size_t)l * DM * DFF, scr, r, lane);
        }
    }
}

__device__ __forceinline__ void phase_modnorm(const float* xin, const float* mb  , int off_sh, int off_sc, bfu* HN, int row0, int nrows, int lane, int wave) {
    for (int m = row0 + wave; m < row0 + nrows; m += NWAVES) {
        const f32x4* xr = (const f32x4*)(xin + (size_t)m * DM) + lane;
        f32x4 v[4]; float s = 0.f;
#pragma unroll
        for (int j = 0; j < 4; ++j) { v[j] = xr[64 * j]; s += (v[j][0] * v[j][0] + v[j][1] * v[j][1]) + (v[j][2] * v[j][2] + v[j][3] * v[j][3]); }
        const float rs = rsqrtf(wave_sum(s) * (1.f / DM) + 1e-6f);
        unsigned long long* o8 = (unsigned long long*)(HN + (size_t)m * DM) + lane;
#pragma unroll
        for (int j = 0; j < 4; ++j) { const f32x4 sc = *((const f32x4*)(mb + off_sc) + lane + 64 * j), sh = *((const f32x4*)(mb + off_sh) + lane + 64 * j);
            const f32x4 y = v[j] * rs * (sc + 1.0f) + sh;
            o8[64 * j] = (unsigned long long)pkbf(y[0], y[1]) | ((unsigned long long)pkbf(y[2], y[3]) << 32); }
    }
}
__device__ __forceinline__ void phase_finalnorm(float* x, const float* gain, int row0, int nrows, int lane, int wave) {
    for (int m = row0 + wave; m < row0 + nrows; m += NWAVES) {
        f32x4* xr = (f32x4*)(x + (size_t)m * DM) + lane;
        f32x4 v[4]; float s = 0.f;
#pragma unroll
        for (int j = 0; j < 4; ++j) { v[j] = xr[64 * j]; s += (v[j][0] * v[j][0] + v[j][1] * v[j][1]) + (v[j][2] * v[j][2] + v[j][3] * v[j][3]); }
        const float rs = rsqrtf(wave_sum(s) * (1.f / DM) + 1e-6f);
#pragma unroll
        for (int j = 0; j < 4; ++j) { const f32x4 g = *((const f32x4*)gain + lane + 64 * j); xr[64 * j] = v[j] * rs * g; }
    }
}

__device__ __forceinline__ void unpack8(const v4u r, float (&v)[8]) {
#pragma unroll
    for (int i = 0; i < 4; ++i) { v[2 * i] = __uint_as_float(r[i] << 16); v[2 * i + 1] = __uint_as_float(r[i] & 0xffff0000u); }
}
__device__ __forceinline__ v4u pack8(const float (&v)[8]) { v4u o; o[0] = pkbf(v[0], v[1]); o[1] = pkbf(v[2], v[3]); o[2] = pkbf(v[4], v[5]); o[3] = pkbf(v[6], v[7]); return o; }
__device__ __forceinline__ void rope8(float (&v)[8], const float* tab, bool second) {
    float pv[8];
#pragma unroll
    for (int k = 0; k < 8; ++k) pv[k] = __shfl_xor(v[k], 2);
#pragma unroll
    for (int k4 = 0; k4 < 4; ++k4) { const f32x4 cs = *(const f32x4*)(tab + 4 * k4);
        const int k = 2 * k4;
        v[k] = second ? v[k] * cs[0] + pv[k] * cs[1] : v[k] * cs[0] - pv[k] * cs[1];
        v[k + 1] = second ? v[k + 1] * cs[2] + pv[k + 1] * cs[3] : v[k + 1] * cs[2] - pv[k + 1] * cs[3]; }
}
__device__ __forceinline__ void phase_post(const Params& p, unsigned char* slab, int l, int row0, int nrows, int lane, int wave) {
    const bfu* Z = (const bfu*)(slab + SL_Z); const float* ROPE = (const float*)(p.ws + WS_ROPE);
    bfu* QA = (bfu*)(slab + SL_QA); bfu* KA = (bfu*)(slab + SL_KA); bfu* QB = (bfu*)(slab + SL_QB); bfu* KB = (bfu*)(slab + SL_KB);
    const float C2A = 0.125f * attn_body::LOG2E, C2B = 0.17677669529663687f * attn_body::LOG2E;
    for (int m = row0 + wave; m < row0 + nrows; m += NWAVES) {
        const int s = m, prow = s >> 6, pcol = s & 63;
        const bfu* zr = Z + (size_t)m * NIN;
        {
            const int head = lane >> 3, ch = lane & 7;
            float v[8]; unpack8(*(const v4u*)(zr + head * 64 + ch * 8), v);
            float ss = 0.f;
#pragma unroll
            for (int k = 0; k < 8; ++k) ss += v[k] * v[k];
            ss += __shfl_xor(ss, 1); ss += __shfl_xor(ss, 2); ss += __shfl_xor(ss, 4);
            const float rs = rsqrtf(ss * (1.f / 64.f) + 1e-6f);
            const float* gp = p.a_qk_norm + l * 128 + (head < 6 ? 0 : 64) + ch * 8;
            const f32x4 g0 = *(const f32x4*)gp, g1 = *(const f32x4*)(gp + 4);
#pragma unroll
            for (int k = 0; k < 4; ++k) { v[k] *= rs * g0[k]; v[k + 4] *= rs * g1[k]; }
            const int pos = (ch & 4) ? pcol : prow;
            rope8(v, ROPE + (pos * 16 + 8 * (ch & 1)) * 2, (ch & 2) != 0);
            if (head < 6) {
#pragma unroll
                for (int k = 0; k < 8; ++k) v[k] *= C2A;
                *(v4u*)(QA + (size_t)m * 384 + head * 64 + ch * 8) = pack8(v);
            } else *(v4u*)(KA + (size_t)m * 128 + (head - 6) * 64 + ch * 8) = pack8(v);
        }
        {
            const bool act = lane < 48; const int ln = act ? lane : lane - 48;
            const int hc = ln >> 2, ch = ln & 3;
            const float* tab = ROPE + (s * 16 + 8 * (ch & 1)) * 2;
            float v[8]; unpack8(*(const v4u*)(zr + 640 + hc * 32 + ch * 8), v);
            rope8(v, tab, (ch & 2) != 0);
#pragma unroll
            for (int k = 0; k < 8; ++k) v[k] *= C2B;
            if (act) { const int comp = hc & 1; bfu* qd = QB + (size_t)m * 768 + hc * 64;
                *(v4u*)(qd + comp * 32 + ch * 8) = pack8(v); *(v4u*)(qd + (1 - comp) * 32 + ch * 8) = (v4u){0u, 0u, 0u, 0u}; }
            unpack8(*(const v4u*)(zr + 1024 + hc * 32 + ch * 8), v);
            rope8(v, tab, (ch & 2) != 0);
            if (act) *(v4u*)(KB + (size_t)m * 384 + hc * 32 + ch * 8) = pack8(v);
        }
    }
}
namespace hg {
constexpr int PB = 144;
constexpr int QE = 0, QC = 9216, KV = 18432, KLT = 55296, VT = 64512, ST = 73728, PP = 82944, TOT = 92160, AA = 94208, OO = 94464, LDS_BYTES = OO + 64 * 68 * 4;
static_assert(LDS_BYTES <= LDS_TOTAL, "hgrn lds");
#define HG_MFMA(a, b, c) __builtin_amdgcn_mfma_f32_16x16x32_bf16(a, b, c, 0, 0, 0)
#define HG_LD8(off) (*(const LAS bf16x8*)(L + (off)))
__device__ __forceinline__ void hgrn_scan(LAS unsigned char* L, const Params& p, const bfu* Z  , float* OF  , int ofp_, int layer, int h, int dir) {
    int tid_ = threadIdx.x; asm volatile("" : "+v"(tid_));
    const int tid = tid_, lane = tid & 63, g = __builtin_amdgcn_readfirstlane(tid >> 6), fr = lane & 15, fq = lane >> 4;
    const int d = lane;
    float lb = 0.f;
    if (layer == 1) { const float b0 = p.hgrn_lb[h * 64 + d], b1 = p.hgrn_lb[256 + h * 64 + d]; lb = fminf(fmaxf(1.0f / (1.0f + __expf(b0 - b1)), 0.f), 1.f); }
    const float oml = 1.0f - lb;
    const int I = g >> 1, jh = g & 1;
    for (int i = tid; i < 64 * PB / 4; i += NTHR) ((LAS unsigned*)(L + ST))[i] = 0u;
    f32x4 Sreg[2]; Sreg[0] = (f32x4){0.f, 0.f, 0.f, 0.f}; Sreg[1] = Sreg[0];
    const int qcol = 1792 + h * 64 + d, fcol = (dir ? 2304 : 2048) + h * 64 + d, vcol = 2560 + h * 64 + d;
    const long rstep = dir ? -(long)NIN : (long)NIN;
    const bfu* zrow = Z + (size_t)(dir ? 2047 - 8 * g : 8 * g) * NIN;
    unsigned short rq[8], rf[8], rv[8];
#pragma unroll
    for (int j = 0; j < 8; ++j) { const bfu* zr = zrow + rstep * j; rq[j] = zr[qcol]; rf[j] = zr[fcol]; rv[j] = zr[vcol]; }
    for (int c = 0; c < 32; ++c) {
        float bl[8], qv[8], kk[8]; unsigned short vb[8]; float run = 0.f;
#pragma unroll
        for (int j = 0; j < 8; ++j) {
            const float zq = bf2f(rq[j]); float zf = bf2f(rf[j]); vb[j] = rv[j];
            zf = fminf(fmaxf(zf, -30.f), 30.f);
            const float e = __expf(-zf), sig = __builtin_amdgcn_rcpf(1.0f + e);
            const float f = lb + oml * sig;
            run += __logf(fmaxf(f, 1e-6f)); bl[j] = run; kk[j] = oml * e * sig;
            qv[j] = zq * __builtin_amdgcn_rcpf(1.0f + __expf(-zq)) * 0.125f;
        }
        ((LAS float*)(L + TOT))[g * 64 + d] = run;
        if (c < 31) {
            const bfu* zn = zrow + rstep * 64 * (c + 1);
#pragma unroll
            for (int j = 0; j < 8; ++j) { const bfu* zr = zn + rstep * j; rq[j] = zr[qcol]; rf[j] = zr[fcol]; rv[j] = zr[vcol]; }
        }
        __syncthreads();
        float R1 = 0.f, R2 = 0.f, R3 = 0.f, blast, sub = 0.f;
        { float pp = 0.f;
#pragma unroll
          for (int g2 = 0; g2 < 8; ++g2) { const float tv = ((const LAS float*)(L + TOT))[g2 * 64 + d]; if (g2 == 2) R1 = pp; if (g2 == 4) R2 = pp; if (g2 == 6) R3 = pp; if (g2 + 1 == g && jh == 1) sub = tv; pp += tv; }
          blast = pp; }
        const float RI = I == 0 ? 0.f : (I == 1 ? R1 : (I == 2 ? R2 : R3));
        const float EI = __expf(RI), F1 = __expf(R1 - RI), F2 = __expf(R2 - RI), F3 = __expf(R3 - RI), GL = __expf(blast - RI);
#pragma unroll
        for (int j = 0; j < 8; ++j) {
            const int t = 8 * g + j; const float lc = sub + bl[j];
            const float qe = qv[j] * __expf(lc), kb = kk[j] * __expf(fminf(-lc, 80.f));
            *(LAS unsigned short*)(L + QE + t * PB + d * 2) = f2bf1(qe);
            *(LAS unsigned short*)(L + QC + t * PB + d * 2) = f2bf1(qe * EI);
            if (I == 0) *(LAS unsigned short*)(L + KV + 0 * 9216 + t * PB + d * 2) = f2bf1(kb);
            if (I <= 1) *(LAS unsigned short*)(L + KV + 1 * 9216 + t * PB + d * 2) = f2bf1(I == 1 ? kb : kb * F1);
            if (I <= 2) *(LAS unsigned short*)(L + KV + 2 * 9216 + t * PB + d * 2) = f2bf1(I == 2 ? kb : kb * F2);
            *(LAS unsigned short*)(L + KV + 3 * 9216 + t * PB + d * 2) = f2bf1(I == 3 ? kb : kb * F3);
            bl[j] = kb * GL;
        }
        { unsigned klp[4], vp[4];
#pragma unroll
          for (int j = 0; j < 4; ++j) { klp[j] = pkbf(bl[2 * j], bl[2 * j + 1]); vp[j] = (unsigned)vb[2 * j] | ((unsigned)vb[2 * j + 1] << 16); }
          *(LAS v4u*)(L + KLT + d * PB + g * 16) = (v4u){klp[0], klp[1], klp[2], klp[3]};
          *(LAS v4u*)(L + VT + d * PB + g * 16) = (v4u){vp[0], vp[1], vp[2], vp[3]}; }
        if (g == 0) ((LAS float*)(L + AA))[d] = __expf(blast);
        __syncthreads();
#pragma unroll
        for (int jj = 0; jj < 2; ++jj) { const int Jb = 2 * jh + jj;
            f32x4 acc = (f32x4){0.f, 0.f, 0.f, 0.f};
            if (Jb <= I) {
#pragma unroll
                for (int k2 = 0; k2 < 2; ++k2) acc = HG_MFMA(HG_LD8(QE + (16 * I + fr) * PB + (k2 * 32 + 8 * fq) * 2), HG_LD8(KV + I * 9216 + (16 * Jb + fr) * PB + (k2 * 32 + 8 * fq) * 2), acc);
            }
#pragma unroll
            for (int i = 0; i < 4; ++i) { const float val = (Jb < I || (Jb == I && fr <= 4 * fq + i)) ? acc[i] : 0.f;
                *(LAS unsigned short*)(L + PP + (16 * I + 4 * fq + i) * PB + (16 * Jb + fr) * 2) = f2bf1(val); }
        }
        __syncthreads();
        const f32x4 a4 = *(const LAS f32x4*)(L + AA + (16 * I + 4 * fq) * 4);
#pragma unroll
        for (int nn = 0; nn < 2; ++nn) { const int n = 2 * jh + nn;
            f32x4 acc = (f32x4){0.f, 0.f, 0.f, 0.f};
#pragma unroll
            for (int k2 = 0; k2 < 2; ++k2) acc = HG_MFMA(HG_LD8(PP + (16 * I + fr) * PB + (k2 * 32 + 8 * fq) * 2), HG_LD8(VT + (16 * n + fr) * PB + (k2 * 32 + 8 * fq) * 2), acc);
#pragma unroll
            for (int k2 = 0; k2 < 2; ++k2) acc = HG_MFMA(HG_LD8(QC + (16 * I + fr) * PB + (k2 * 32 + 8 * fq) * 2), HG_LD8(ST + (16 * n + fr) * PB + (k2 * 32 + 8 * fq) * 2), acc);
#pragma unroll
            for (int i = 0; i < 4; ++i) ((LAS float*)(L + OO))[(16 * I + 4 * fq + i) * 68 + 16 * n + fr] = acc[i];
            f32x4 sr = Sreg[nn] * a4;
#pragma unroll
            for (int k2 = 0; k2 < 2; ++k2) sr = HG_MFMA(HG_LD8(KLT + (16 * I + fr) * PB + (k2 * 32 + 8 * fq) * 2), HG_LD8(VT + (16 * n + fr) * PB + (k2 * 32 + 8 * fq) * 2), sr);
            Sreg[nn] = sr;
        }
        __syncthreads();
#pragma unroll
        for (int nn = 0; nn < 2; ++nn) { const int n = 2 * jh + nn;
            *(LAS v2u*)(L + ST + (16 * n + fr) * PB + (16 * I + 4 * fq) * 2) = (v2u){pkbf(Sreg[nn][0], Sreg[nn][1]), pkbf(Sreg[nn][2], Sreg[nn][3])}; }
        {
            const int t = tid >> 3, j8 = tid & 7;
            const f32x4 o0 = *(const LAS f32x4*)(L + OO + (t * 68 + 8 * j8) * 4), o1 = *(const LAS f32x4*)(L + OO + (t * 68 + 8 * j8 + 4) * 4);
            const size_t row = (size_t)(dir ? 2047 - (64 * c + t) : 64 * c + t);
            float* ofp = OF + row * ofp_ + h * 64 + 8 * j8;
            *(f32x4*)ofp = o0; *(f32x4*)(ofp + 4) = o1;
        }
    }
    __threadfence();
    __syncthreads();
}
__device__ __forceinline__ void hgrn_combine(const Params& p, const bfu* Z, const float* OFf  , const float* OFb  , bfu* MIX  , int layer, int row0) {
    int tid = threadIdx.x; asm volatile("" : "+v"(tid));
    const float* gain = p.hgrn_norm + layer * 64;
#pragma unroll 2
    for (int k = 0; k < 16; ++k) {
        const int idx = tid + NTHR * k, r = idx >> 5, cgp = idx & 31; const size_t row = (size_t)row0 + r; const int col = 8 * cgp;
        const unsigned long long* pf = (const unsigned long long*)(OFf + row * 256 + col); const unsigned long long* pb = (const unsigned long long*)(OFb + row * 512 + col);
        float sv[8];
#pragma unroll
        for (int q = 0; q < 4; ++q) { const unsigned long long wf = __hip_atomic_load(pf + q, __ATOMIC_RELAXED, __HIP_MEMORY_SCOPE_AGENT), wb = __hip_atomic_load(pb + q, __ATOMIC_RELAXED, __HIP_MEMORY_SCOPE_AGENT);
            sv[2 * q] = __uint_as_float((unsigned)wf) + __uint_as_float((unsigned)wb); sv[2 * q + 1] = __uint_as_float((unsigned)(wf >> 32)) + __uint_as_float((unsigned)(wb >> 32)); }
        float ss = 0.f;
#pragma unroll
        for (int q = 0; q < 8; ++q) ss += sv[q] * sv[q];
        ss += __shfl_xor(ss, 1); ss += __shfl_xor(ss, 2); ss += __shfl_xor(ss, 4);
        const float rs = rsqrtf(ss * (1.f / 64.f) + 1e-6f);
        float zg[8]; unpack8(*(const v4u*)(Z + row * NIN + 2816 + col), zg);
        const f32x4 g0 = *(const f32x4*)(gain + (col & 63)), g1 = *(const f32x4*)(gain + (col & 63) + 4);
#pragma unroll
        for (int q = 0; q < 4; ++q) { sv[q] = sv[q] * rs * g0[q] * (zg[q] * sigmoidf_(zg[q])); sv[q + 4] = sv[q + 4] * rs * g1[q] * (zg[q + 4] * sigmoidf_(zg[q + 4])); }
        *(v4u*)(MIX + row * DM + 768 + col) = pack8(sv);
    }
}
#undef HG_MFMA
#undef HG_LD8
}
struct TileOrder {
    int pm, nN;
    __device__ __forceinline__ bool next(int i, pg8::Unit& u) const { if (i >= nN) return false; u.pm = pm; u.pn = i; return true; }
    __device__ __forceinline__ void a_ready(const pg8::Unit&) const {}
    __device__ __forceinline__ void done(const pg8::Unit&) const {}
};
__device__ __forceinline__ void group_barrier(unsigned* ctr, unsigned target) {
    asm volatile("s_waitcnt vmcnt(0)" ::: "memory");
    __syncthreads();
    if (threadIdx.x == 0) {
        __builtin_amdgcn_fence(__ATOMIC_RELEASE, "agent");
        asm volatile("s_waitcnt vmcnt(0)" ::: "memory");
        __hip_atomic_fetch_add(ctr, 1u, __ATOMIC_RELAXED, __HIP_MEMORY_SCOPE_AGENT);
        unsigned sp = 0;
        while (__hip_atomic_load(ctr, __ATOMIC_RELAXED, __HIP_MEMORY_SCOPE_AGENT) < target) { __builtin_amdgcn_s_sleep(2); if (++sp > (1u << 24)) break; }
        __builtin_amdgcn_fence(__ATOMIC_ACQUIRE, "agent");
        asm volatile("s_waitcnt vmcnt(0)" ::: "memory");
    }
    __syncthreads();
}
__device__ __forceinline__ void local_seam() {
    asm volatile("s_waitcnt vmcnt(0)" ::: "memory");
    __syncthreads();
    if (threadIdx.x == 0) { __builtin_amdgcn_fence(__ATOMIC_ACQUIRE, "agent"); asm volatile("s_waitcnt vmcnt(0)" ::: "memory"); }
    __syncthreads();
}

__device__ __forceinline__ void phase_mixer(const Params& p, int l, int bt, int r, LAS unsigned char* lds) {
    using attn_body::bf16;
    unsigned char* slab = p.ws + WS_SLAB + (size_t)bt * SLAB;
    const bf16* Z = (const bf16*)(slab + SL_Z); bf16* MIX = (bf16*)(p.ws + WS_MIX) + (size_t)bt * SEQ * DM;
    const bf16* QA = (const bf16*)(slab + SL_QA); const bf16* KA = (const bf16*)(slab + SL_KA); const bf16* QB = (const bf16*)(slab + SL_QB); const bf16* KB = (const bf16*)(slab + SL_KB);
    { const int dir = r & 1;
      float* OF = dir ? (float*)((bfu*)(p.ws + WS_HN) + (size_t)bt * SEQ * DM) : (float*)(p.ws + WS_OF) + (size_t)bt * SEQ * 256;
      hg::hgrn_scan(lds, p, (const bfu*)(slab + SL_Z), OF, dir ? 512 : 256, l, r >> 1, dir); }
    float lam;
    { const float* lp = p.diff_lambda + l * 128; float s1 = 0.f, s2 = 0.f;
      for (int i = 0; i < 32; ++i) { s1 += lp[i] * lp[32 + i]; s2 += lp[64 + i] * lp[96 + i]; }
      const float lam_init = (l == 0) ? 0.2f : (0.8f - 0.6f * 0.7408182206817179f);
      lam = expf(s1) - expf(s2) + lam_init; }
    lam = __uint_as_float(__builtin_amdgcn_readfirstlane(__float_as_uint(lam)));
    const float lam_init = (l == 0) ? 0.2f : (0.8f - 0.6f * 0.7408182206817179f);
    const size_t rq = (size_t)r * 256;
#pragma unroll 1
    for (int h = 0; h < 6; ++h) {
        attn_body::AttnJob J;
        J.Q = QB + rq * 768 + h * 128; J.qp = 768; J.K = KB + h * 64; J.kp = 384; J.V = Z + 1408 + h * 64; J.vp = NIN;
        J.O = MIX + rq * DM + 384 + h * 64; J.op = DM; J.npass = 2; J.lam = lam; J.gain = p.diff_subln + l * 64; J.oscale = 1.0f - lam_init;
        attn_body::attn_unit<8>(J, (char*)lds);
    }
#pragma unroll 1
    for (int head = 0; head < 6; ++head) {
        attn_body::AttnJob J; const int kvh = head / 3;
        J.Q = QA + rq * 384 + head * 64; J.qp = 384; J.K = KA + kvh * 64; J.kp = 128; J.V = Z + 512 + kvh * 64; J.vp = NIN;
        J.O = MIX + rq * DM + head * 64; J.op = DM; J.npass = 1; J.lam = 0.f; J.gain = p.diff_subln; J.oscale = 1.f;
        attn_body::attn_unit<8>(J, (char*)lds);
    }
}

typedef const __attribute__((address_space(4))) Params* KParams;
__device__ __forceinline__ Params ldp() {
#if defined(__HIP_DEVICE_COMPILE__)
    KParams k = (KParams)__builtin_amdgcn_kernarg_segment_ptr(); asm volatile("" : "+s"(k)); Params r;
    r.x = k->x; r.c = k->c; r.w_mod = k->w_mod; r.b_mod = k->b_mod; r.w_in = k->w_in; r.a_qk_norm = k->a_qk_norm; r.diff_lambda = k->diff_lambda; r.diff_subln = k->diff_subln; r.hgrn_lb = k->hgrn_lb;
    r.hgrn_norm = k->hgrn_norm; r.w_out = k->w_out; r.w_ff1 = k->w_ff1; r.w_ff2 = k->w_ff2; r.final_norm = k->final_norm; r.out = k->out; r.ws = k->ws; return r;
#else
    return Params{};
#endif
}
#define TID_LANE_WAVE int tid = threadIdx.x; asm volatile("" : "+v"(tid)); const int lane = tid & 63, wave = __builtin_amdgcn_readfirstlane(tid >> 6); (void)lane; (void)wave;
template <int l> __device__ __forceinline__ void layer_body(LAS unsigned char* lds, const int bt, const int r) {
        { TID_LANE_WAVE const Params p = ldp(); const float* xin = ((l == 0) ? p.x : p.out) + (size_t)bt * SEQ * DM;
          phase_modnorm(xin, (const float*)(p.ws + WS_MOD) + ((size_t)l * BATCH + bt) * NMOD, 0, 1024, (bfu*)(p.ws + WS_HN) + (size_t)bt * SEQ * DM, 256 * r, 256, lane, wave); }
        local_seam();
        {
            const Params p = ldp(); unsigned char* slab = p.ws + WS_SLAB + (size_t)bt * SLAB;
            pg8::Gemm g{(const bfu*)(p.ws + WS_HN) + (size_t)bt * SEQ * DM, (const bfu*)(p.ws + WS_WIN) + (size_t)l * NIN * DM, SEQ, NIN, DM}; TileOrder S{r, NIN / 256};
            pg8::EpiBf16<0> E{(bfu*)(slab + SL_Z), NIN};
            pg8::gemm_phase<pg8::EpiBf16<0>, TileOrder, PG8_ALIGN, PG8_SP2>(lds, g, S, E);
        }
        local_seam();
        { TID_LANE_WAVE const Params p = ldp(); phase_post(p, p.ws + WS_SLAB + (size_t)bt * SLAB, l, 256 * r, 256, lane, wave); }
        { const Params p = ldp(); group_barrier((unsigned*)(p.ws + WS_CTL) + 64 * bt, 8u * (3 * l + 1)); }
        { const Params p = ldp(); phase_mixer(p, l, bt, r, lds); }
        { const Params p = ldp(); group_barrier((unsigned*)(p.ws + WS_CTL) + 64 * bt, 8u * (3 * l + 2)); }
        { const Params p = ldp(); unsigned char* slab = p.ws + WS_SLAB + (size_t)bt * SLAB;
          hg::hgrn_combine(p, (const bfu*)(slab + SL_Z), (const float*)(p.ws + WS_OF) + (size_t)bt * SEQ * 256, (const float*)((const bfu*)(p.ws + WS_HN) + (size_t)bt * SEQ * DM),
                           (bfu*)(p.ws + WS_MIX) + (size_t)bt * SEQ * DM, l, 256 * r); }
        { const Params p = ldp(); group_barrier((unsigned*)(p.ws + WS_CTL) + 64 * bt, 8u * (3 * l + 3)); }
        {
            const Params p = ldp();
            pg8::Gemm g{(const bfu*)(p.ws + WS_MIX) + (size_t)bt * SEQ * DM, (const bfu*)(p.ws + WS_WOUT) + (size_t)l * DM * DM, SEQ, DM, DM}; TileOrder S{r, DM / 256};
            pg8::EpiResGate E{((l == 0) ? p.x : p.out) + (size_t)bt * SEQ * DM, p.out + (size_t)bt * SEQ * DM, (const float*)(p.ws + WS_MOD) + ((size_t)l * BATCH + bt) * NMOD + 2048};
            pg8::gemm_phase<pg8::EpiResGate, TileOrder, PG8_ALIGN, PG8_SP2>(lds, g, S, E);
        }
        local_seam();
        { TID_LANE_WAVE const Params p = ldp();
          phase_modnorm(p.out + (size_t)bt * SEQ * DM, (const float*)(p.ws + WS_MOD) + ((size_t)l * BATCH + bt) * NMOD, 3072, 4096, (bfu*)(p.ws + WS_HN) + (size_t)bt * SEQ * DM, 256 * r, 256, lane, wave); }
        local_seam();
        {
            const Params p = ldp(); unsigned char* slab = p.ws + WS_SLAB + (size_t)bt * SLAB;
            pg8::Gemm g{(const bfu*)(p.ws + WS_HN) + (size_t)bt * SEQ * DM, (const bfu*)(p.ws + WS_WFF1) + (size_t)l * DFF * DM, SEQ, DFF, DM}; TileOrder S{r, DFF / 256};
            pg8::EpiBf16<2> E{(bfu*)(slab + SL_HID), DFF};
            pg8::gemm_phase<pg8::EpiBf16<2>, TileOrder, PG8_ALIGN, PG8_SP2>(lds, g, S, E);
        }
        local_seam();
        {
            const Params p = ldp(); unsigned char* slab = p.ws + WS_SLAB + (size_t)bt * SLAB;
            pg8::Gemm g{(const bfu*)(slab + SL_HID), (const bfu*)(p.ws + WS_WFF2) + (size_t)l * DM * DFF, SEQ, DM, DFF}; TileOrder S{r, DM / 256};
            pg8::EpiResGate E{p.out + (size_t)bt * SEQ * DM, p.out + (size_t)bt * SEQ * DM, (const float*)(p.ws + WS_MOD) + ((size_t)l * BATCH + bt) * NMOD + 5120};
            pg8::gemm_phase<pg8::EpiResGate, TileOrder, PG8_ALIGN, PG8_SP2>(lds, g, S, E);
        }
        local_seam();
    }
__global__ void __launch_bounds__(NTHR, 2) fwd_megakernel(Params p_unused) {
    extern __shared__ __attribute__((aligned(16))) unsigned char lds_raw[];
    LAS unsigned char* lds = (LAS unsigned char*)lds_raw;
    cg::grid_group grid = cg::this_grid();
    { TID_LANE_WAVE const Params p = ldp(); phase_prologue(p, lds, tid, lane, wave); }
    grid.sync();
    const int bt = (int)(((blockIdx.x & 7u) << 2) | ((blockIdx.x >> 3) & 3u)), r = (int)(blockIdx.x >> 5);
    layer_body<0>(lds, bt, r);
    layer_body<1>(lds, bt, r);
    { TID_LANE_WAVE const Params p = ldp(); phase_finalnorm(p.out + (size_t)bt * SEQ * DM, p.final_norm, 256 * r, 256, lane, wave); }
}

extern "C" void kernel_launch(void* const* d_in, const int* in_sizes, int n_in, void* d_out, int out_size, void* d_ws, size_t ws_size, hipStream_t stream) {
    static int grid = 0;
    if (grid == 0) {
        if (n_in != 14 || in_sizes[0] != M * DM || out_size != M * DM || ws_size < WS_END) { fprintf(stderr, "kernel_launch: unexpected shapes (n_in %d in0 %d out %d ws %zu)\n", n_in, n_in > 0 ? in_sizes[0] : -1, out_size, ws_size); grid = -1; return; }
        int dev = 0, cus = 0, per_cu = 0;
        hipGetDevice(&dev); hipDeviceGetAttribute(&cus, hipDeviceAttributeMultiprocessorCount, dev);
        if (hipFuncSetAttribute((const void*)fwd_megakernel, hipFuncAttributeMaxDynamicSharedMemorySize, LDS_TOTAL) != hipSuccess) { fprintf(stderr, "kernel_launch: hipFuncSetAttribute failed\n"); grid = -1; return; }
        if (hipOccupancyMaxActiveBlocksPerMultiprocessor(&per_cu, (const void*)fwd_megakernel, NTHR, LDS_TOTAL) != hipSuccess || per_cu < 1) { fprintf(stderr, "kernel_launch: occupancy query says %d\n", per_cu); per_cu = 1; }
        (void)hipGetLastError();
        grid = cus * 1;
        (void)per_cu;
    }
    if (grid < 0) return;
    hipMemsetAsync((char*)d_ws + WS_CTL, 0, CTL_ZERO_BYTES, stream);
    Params p{};
    p.x = (const float*)d_in[0]; p.c = (const float*)d_in[1]; p.w_mod = (const float*)d_in[2]; p.b_mod = (const float*)d_in[3]; p.w_in = (const float*)d_in[4];
    p.a_qk_norm = (const float*)d_in[5]; p.diff_lambda = (const float*)d_in[6]; p.diff_subln = (const float*)d_in[7]; p.hgrn_lb = (const float*)d_in[8]; p.hgrn_norm = (const float*)d_in[9];
    p.w_out = (const float*)d_in[10]; p.w_ff1 = (const float*)d_in[11]; p.w_ff2 = (const float*)d_in[12]; p.final_norm = (const float*)d_in[13];
    p.out = (float*)d_out; p.ws = (unsigned char*)d_ws;
    void* args[] = {&p};
    hipError_t e = hipLaunchCooperativeKernel((const void*)fwd_megakernel, dim3(grid), dim3(NTHR), args, LDS_TOTAL, stream);
    if (e != hipSuccess) fprintf(stderr, "cooperative launch failed: %s (grid %d)\n", hipGetErrorString(e), grid);
}
```
